# Optimizing an MI355X kernel written in HIP

```python
import math
import jax, jax.numpy as jnp
from jax import lax
import numpy as np

D_MODEL = 1024
BATCH = 16
SEQ = 2048
DEPTH = 1
DEC_BATCH = 32
DEC_SEQ = 32
PAST_LEN = 2048

CHUNK = 64
N_META = 16
ATT_HEADS = 8
HEAD_DIM = 64
ATT_WIDTH = ATT_HEADS * HEAD_DIM
CONV_CH = D_MODEL - ATT_WIDTH
CONV_K = 31
D_FF = 4 * D_MODEL
Q_BLOCK = 128
IN_COLS = 3 * ATT_WIDTH + 2 * CONV_CH
ALPHA = (2.0 * DEPTH) ** 0.25
BETA_INIT = (8.0 * DEPTH) ** -0.25
LN_EPS = 1e-5

kernel_name = "hymba_stickbreak_conformer_stream_step"


def layer_norm(x, g, b):
    xf = x.astype(jnp.float32)
    mu = jnp.mean(xf, axis=-1, keepdims=True)
    var = jnp.mean(jnp.square(xf - mu), axis=-1, keepdims=True)
    y = (xf - mu) * lax.rsqrt(var + LN_EPS) * g.astype(jnp.float32) + b.astype(jnp.float32)
    return y.astype(x.dtype)


def project_in(h, w):
    B, T, _ = h.shape
    p = h @ w
    q, k, v, a, gate = jnp.split(
        p, [ATT_WIDTH, 2 * ATT_WIDTH, 3 * ATT_WIDTH, 3 * ATT_WIDTH + CONV_CH], axis=-1)
    shp = (B, T, ATT_HEADS, HEAD_DIM)
    return q.reshape(shp), k.reshape(shp), v.reshape(shp), a, gate


def stick_breaking_block(q, k, v, q_pos, k_pos):
    z = jnp.einsum('bqhd,bshd->bhqs', q, k).astype(jnp.float32) / math.sqrt(HEAD_DIM)
    mask = k_pos[None, :] < q_pos[:, None]
    log_beta = jax.nn.log_sigmoid(z)
    log_1m = jnp.where(mask, jax.nn.log_sigmoid(-z), 0.0)
    suffix = lax.cumsum(log_1m, axis=3, reverse=True) - log_1m
    a = jnp.where(mask, jnp.exp(log_beta + suffix), 0.0)
    return jnp.einsum('bhqs,bshd->bqhd', a.astype(v.dtype), v)


def stick_breaking_prompt(q, k, v):
    B, L, H, dh = q.shape
    nb = -(-L // Q_BLOCK)
    lp = nb * Q_BLOCK
    qp = jnp.pad(q, ((0, 0), (0, lp - L), (0, 0), (0, 0)))
    q_blocks = qp.reshape(B, nb, Q_BLOCK, H, dh).transpose(1, 0, 2, 3, 4)
    pos_blocks = jnp.arange(lp, dtype=jnp.int32).reshape(nb, Q_BLOCK)
    k_pos = jnp.arange(L, dtype=jnp.int32)
    out = lax.map(lambda qb: stick_breaking_block(qb[0], k, v, qb[1], k_pos),
                  (q_blocks, pos_blocks))
    return out.transpose(1, 0, 2, 3, 4).reshape(B, lp, H, dh)[:, :L]


def conv_module(a, gate, buf, w_dw, b_dw, g_c, b_c):
    u = a * jax.nn.sigmoid(gate)
    xp = jnp.concatenate([buf, u], axis=1)
    c = lax.conv_general_dilated(
        xp, w_dw[:, None, :], window_strides=(1,), padding='VALID',
        dimension_numbers=('NWC', 'WIO', 'NWC'), feature_group_count=CONV_CH)
    c = jax.nn.silu(layer_norm(c + b_dw, g_c, b_c))
    return c, xp[:, -(CONV_K - 1):]


def layer_tail(h, att, conv, w_out, g1, b1, w_ff1, w_ff2, g2, b2):
    B, T, _ = h.shape
    mix = jnp.concatenate([att.reshape(B, T, ATT_WIDTH), conv], axis=-1) @ w_out
    h1 = layer_norm(ALPHA * h + mix, g1, b1)
    f = jnp.square(jax.nn.relu(h1 @ w_ff1)) @ w_ff2
    return layer_norm(ALPHA * h1 + f, g2, b2)


def setup_inputs(seed: int = 0) -> dict:
    key = jax.random.key(seed)
    ks = jax.random.split(key, 20)
    f32 = jnp.float32
    nrm = lambda k, s, sc: jax.random.normal(k, s, f32) * sc
    return {
        "x_prompt": nrm(ks[0], (BATCH, SEQ, D_MODEL), 1.0),
        "x_sample": nrm(ks[1], (DEC_BATCH, DEC_SEQ, D_MODEL), 1.0),
        "cache_k": nrm(ks[2], (DEPTH, DEC_BATCH, PAST_LEN, ATT_HEADS, HEAD_DIM), 1.0),
        "cache_v": nrm(ks[3], (DEPTH, DEC_BATCH, PAST_LEN, ATT_HEADS, HEAD_DIM), 1.0),
        "state_conv": nrm(ks[4], (DEPTH, DEC_BATCH, CONV_K - 1, CONV_CH), 0.5),
        "meta": nrm(ks[5], (N_META, D_MODEL), 1.0),
        "g_in": 1.0 + nrm(ks[6], (D_MODEL,), 0.02),
        "b_in": nrm(ks[7], (D_MODEL,), 0.02),
        "w_in": nrm(ks[8], (DEPTH, D_MODEL, IN_COLS), D_MODEL ** -0.5),
        "w_dw": nrm(ks[9], (DEPTH, CONV_K, CONV_CH), CONV_K ** -0.5),
        "b_dw": nrm(ks[10], (DEPTH, CONV_CH), 0.02),
        "g_conv": 1.0 + nrm(ks[11], (DEPTH, CONV_CH), 0.02),
        "b_conv": nrm(ks[12], (DEPTH, CONV_CH), 0.02),
        "w_out": nrm(ks[13], (DEPTH, D_MODEL, D_MODEL), D_MODEL ** -0.5 * BETA_INIT),
        "g_ln1": 1.0 + nrm(ks[14], (DEPTH, D_MODEL), 0.02),
        "b_ln1": nrm(ks[15], (DEPTH, D_MODEL), 0.02),
        "w_ff1": nrm(ks[16], (DEPTH, D_MODEL, D_FF), D_MODEL ** -0.5),
        "w_ff2": nrm(ks[17], (DEPTH, D_FF, D_MODEL), D_FF ** -0.5 * BETA_INIT),
        "g_ln2": 1.0 + nrm(ks[18], (DEPTH, D_MODEL), 0.02),
        "b_ln2": nrm(ks[19], (DEPTH, D_MODEL), 0.02),
    }


def reference(x_prompt, x_sample, cache_k, cache_v, state_conv, meta, g_in, b_in, w_in,
              w_dw, b_dw, g_conv, b_conv, w_out, g_ln1, b_ln1, w_ff1, w_ff2, g_ln2, b_ln2):
    B = x_prompt.shape[0]
    DB, n = x_sample.shape[0], x_sample.shape[1]
    P = cache_k.shape[2]
    meta_b = jnp.broadcast_to(meta[None].astype(x_prompt.dtype), (B, N_META, D_MODEL))
    hp = layer_norm(jnp.concatenate([meta_b, x_prompt], axis=1), g_in, b_in)
    hs = layer_norm(x_sample, g_in, b_in)
    q_pos_s = P + jnp.arange(n, dtype=jnp.int32)
    k_pos_s = jnp.arange(P + n, dtype=jnp.int32)
    kp_l, vp_l, cp_l, ks_l, vs_l, cs_l = [], [], [], [], [], []
    for l in range(DEPTH):
        qp, kp, vp, ap, gp = project_in(hp, w_in[l])
        att_p = stick_breaking_prompt(qp, kp, vp)
        buf0 = jnp.zeros((B, CONV_K - 1, CONV_CH), ap.dtype)
        conv_p, cst_p = conv_module(ap, gp, buf0, w_dw[l], b_dw[l], g_conv[l], b_conv[l])
        hp = layer_tail(hp, att_p, conv_p, w_out[l], g_ln1[l], b_ln1[l],
                        w_ff1[l], w_ff2[l], g_ln2[l], b_ln2[l])
        kp_l.append(kp); vp_l.append(vp); cp_l.append(cst_p)
        qs, kn, vn, an, gn = project_in(hs, w_in[l])
        k_all = jnp.concatenate([cache_k[l].astype(kn.dtype), kn], axis=1)
        v_all = jnp.concatenate([cache_v[l].astype(vn.dtype), vn], axis=1)
        att_s = stick_breaking_block(qs, k_all, v_all, q_pos_s, k_pos_s)
        conv_s, cst_s = conv_module(an, gn, state_conv[l].astype(an.dtype),
                                    w_dw[l], b_dw[l], g_conv[l], b_conv[l])
        hs = layer_tail(hs, att_s, conv_s, w_out[l], g_ln1[l], b_ln1[l],
                        w_ff1[l], w_ff2[l], g_ln2[l], b_ln2[l])
        ks_l.append(kn); vs_l.append(vn); cs_l.append(cst_s)
    y_prompt = hp[:, N_META:]
    return (y_prompt, hs, jnp.stack(kp_l), jnp.stack(vp_l), jnp.stack(cp_l),
            jnp.stack(ks_l), jnp.stack(vs_l), jnp.stack(cs_l))
```

```cpp
#include <hip/hip_runtime.h>
#include <hip/hip_cooperative_groups.h>
#include <cstdio>
#include <cstdint>
namespace cg = cooperative_groups;
namespace pg8 {
#define PG8_LAS __attribute__((address_space(3)))
typedef unsigned short bf16_t;
typedef short bf16x8 __attribute__((ext_vector_type(8)));
typedef float f32x4 __attribute__((ext_vector_type(4)));
typedef unsigned u32x4 __attribute__((ext_vector_type(4)));
constexpr int BM = 256, BK = 64, HALF = 128, HTB = HALF * BK * 2  , STAGE_BYTES = 8 * HTB, NXCD = 8, WGM = 8;

__host__ __device__ __forceinline__ int lds_byte(int r, int c) { const int st = (r >> 4) * 2 + (c >> 5), rr = r & 15, cc = c & 31, ob = rr * 64 + cc * 2; return st * 1024 + (ob ^ (((ob >> 9) & 1) << 5)); }
__host__ __device__ __forceinline__ void stage_rc(int b, int& R, int& C) { const int st = b / 1024, sb = b % 1024, swz = sb ^ (((sb >> 9) & 1) << 5); R = (st >> 1) * 16 + swz / 64; C = (st & 1) * 32 + (swz % 64) / 2; }
__host__ __device__ __forceinline__ int perm32(int rho) { const int n = rho >> 4, i = rho & 15; return 8 * (i >> 2) + 4 * n + (i & 3); }

struct Unit { int pm, pn, pk; };
struct Gemm { const bf16_t* A; const bf16_t* Bt; int M, N, K, ld; };

struct StaticOrder {
    int nM, nN, nwg, G, c;
    __host__ __device__ void init(int M, int N, int G_, int c_) { nM = M / BM; nN = N / BM; nwg = nM * nN; G = G_; c = c_; }
    __host__ __device__ bool next(int i, Unit& u) const {
        const long L = (long)i * G + c; if (L >= nwg) return false;
        int wgid = (int)L; { const int q = nwg / NXCD, r = nwg % NXCD, xcd = wgid % NXCD, off = wgid / NXCD; wgid = (xcd < r ? xcd * (q + 1) : r * (q + 1) + (xcd - r) * q) + off; }
        const int nig = WGM * nN, gid = wgid / nig, fm = gid * WGM, gsz = (nM - fm) < WGM ? (nM - fm) : WGM;
        u.pm = fm + ((wgid % nig) % gsz); u.pn = (wgid % nig) / gsz; u.pk = 0; return true;
    }
    __device__ __forceinline__ void a_ready(const Unit&) const {}
    __device__ __forceinline__ void done(const Unit&) const {}
};

struct TailOrder {
    int pm0, nN, S, n, G, c;
    __host__ __device__ void init(int pm0_, int nM_, int nN_, int S_, int G_, int c_) { pm0 = pm0_; nN = nN_; S = S_; n = nM_ * nN_ * S_; G = G_; c = c_; }
    __host__ __device__ bool next(int i, Unit& u) const {
        const long L = (long)i * G + c; if (L >= n) return false;
        const int l = (int)L, rem = l / S; u.pk = l - rem * S; u.pn = rem % nN; u.pm = pm0 + rem / nN; return true;
    }
    __device__ __forceinline__ void a_ready(const Unit&) const {}
    __device__ __forceinline__ void done(const Unit&) const {}
};

__device__ __forceinline__ unsigned cvt_pk_bf16(float lo, float hi) { unsigned r; asm volatile("v_cvt_pk_bf16_f32 %0, %1, %2" : "=v"(r) : "v"(lo), "v"(hi)); return r; }
template <class Epi, class Sched, bool ALIGN_EPI = false, bool SP2 = false>
__device__ __forceinline__ void gemm_phase(PG8_LAS unsigned char* lds, const Gemm g, const Sched& S, const Epi& E, int tid_in) {
    int tid_ = tid_in; asm volatile("" : "+v"(tid_));
    const int tid = tid_, wid = __builtin_amdgcn_readfirstlane(tid >> 6), lane = tid & 63, wr = wid >> 2, wc = wid & 3, fr = lane & 15, fq = lane >> 4;
    const int K = g.ld, nt = g.K / BK;
    const size_t kchunk = (size_t)g.K * 2;
    unsigned voffA[2], voffB[2];
#pragma unroll
    for (int i = 0; i < 2; ++i) { int R, C; stage_rc(tid * 16 + i * 8192, R, C); const int Rb = Epi::PERM ? ((R & ~31) + perm32(R & 31)) : R;
        voffA[i] = (unsigned)(R * K + C) * 2u; voffB[i] = (unsigned)(Rb * K + C) * 2u; }
    const size_t kstep = (size_t)(BK * 2);
    const size_t hstep = (size_t)HALF * K * 2;
    const size_t tstep = 2 * hstep;
    const unsigned ldsw = (unsigned)wid * 1024u;
    const int aoff = lds_byte(wr * 64 + fr, fq * 8), boff = lds_byte(wc * 32 + fr, fq * 8);
#define PG8_SA(b, h) (((b) * 2 + (h)) * HTB)
#define PG8_SB(b, h) ((4 + (b) * 2 + (h)) * HTB)
#define PG8_STAGE(bufoff, gbase, voff) do { _Pragma("unroll") for (int _i = 0; _i < 2; ++_i) \
        __builtin_amdgcn_global_load_lds((const unsigned*)((const char*)(gbase) + (voff)[_i]), (PG8_LAS unsigned*)(lds + (bufoff) + ldsw + _i * 8192), 16, 0, 0); } while (0)
#define PG8_LDA(dst, b, h) do { _Pragma("unroll") for (int m = 0; m < 4; ++m) _Pragma("unroll") for (int k = 0; k < 2; ++k) dst[m][k] = *(const PG8_LAS bf16x8*)(lds + PG8_SA(b, h) + aoff + m * 2048 + k * 1024); } while (0)
#define PG8_LDB(dst, b, h) do { _Pragma("unroll") for (int n = 0; n < 2; ++n) _Pragma("unroll") for (int k = 0; k < 2; ++k) dst[n][k] = *(const PG8_LAS bf16x8*)(lds + PG8_SB(b, h) + boff + n * 2048 + k * 1024); } while (0)
#define PG8_MMA(ai, bj, At, Bt) do { __builtin_amdgcn_s_setprio(1); _Pragma("unroll") for (int m = 0; m < 4; ++m) _Pragma("unroll") for (int n = 0; n < 2; ++n) _Pragma("unroll") for (int k = 0; k < 2; ++k) \
        acc[ai][bj][m][n] = __builtin_amdgcn_mfma_f32_16x16x32_bf16(Bt[n][k], At[m][k], acc[ai][bj][m][n], 0, 0, 0); __builtin_amdgcn_s_setprio(0); } while (0)
#define PG8_WAIT_V(n) asm volatile("s_waitcnt vmcnt(" #n ")" ::: "memory")
#define PG8_WAIT_L(n) asm volatile("s_waitcnt lgkmcnt(" #n ")" ::: "memory")
#define PG8_BAR __builtin_amdgcn_s_barrier()
#define PG8_SCHED __builtin_amdgcn_sched_barrier(0)
    Unit cur, nxt; int ui = 0;
    if (!S.next(0, cur)) return;
    f32x4 acc[2][2][4][2];
#pragma unroll
    for (int a = 0; a < 2; ++a)
#pragma unroll
        for (int b = 0; b < 2; ++b)
#pragma unroll
            for (int m = 0; m < 4; ++m)
#pragma unroll
                for (int n = 0; n < 2; ++n) acc[a][b][m][n] = (f32x4){0.f, 0.f, 0.f, 0.f};
    bf16x8 At[4][2], B0[2][2], B1[2][2];
    const char* cA = (const char*)g.A + (size_t)cur.pm * tstep + (size_t)cur.pk * kchunk; const char* cB = (const char*)g.Bt + (size_t)cur.pn * tstep + (size_t)cur.pk * kchunk;
    S.a_ready(cur);
    if constexpr (SP2) {
        PG8_STAGE(PG8_SB(0, 0), cB, voffB); PG8_STAGE(PG8_SB(0, 1), cB + hstep, voffB); PG8_STAGE(PG8_SA(0, 0), cA, voffA); PG8_STAGE(PG8_SA(0, 1), cA + hstep, voffA);
        if (wr == 1) PG8_BAR;
        PG8_WAIT_V(2); PG8_BAR;
        PG8_STAGE(PG8_SB(1, 0), cB + kstep, voffB); PG8_STAGE(PG8_SA(1, 0), cA + kstep, voffA); PG8_STAGE(PG8_SB(1, 1), cB + hstep + kstep, voffB);
        PG8_WAIT_V(6); PG8_BAR;
    } else {
        PG8_STAGE(PG8_SB(0, 0), cB, voffB); PG8_STAGE(PG8_SA(0, 0), cA, voffA); PG8_STAGE(PG8_SB(0, 1), cB + hstep, voffB); PG8_STAGE(PG8_SA(0, 1), cA + hstep, voffA);
        if (wr == 1) PG8_BAR;
        PG8_WAIT_V(4); PG8_BAR;
        PG8_STAGE(PG8_SB(1, 0), cB + kstep, voffB); PG8_STAGE(PG8_SA(1, 0), cA + kstep, voffA); PG8_STAGE(PG8_SB(1, 1), cB + hstep + kstep, voffB);
        PG8_WAIT_V(6); PG8_BAR;
    }
    for (;;) {
        const bool has_next = S.next(ui + 1, nxt);
        const char* nA = has_next ? (const char*)g.A + (size_t)nxt.pm * tstep + (size_t)nxt.pk * kchunk : cA; const char* nB = has_next ? (const char*)g.Bt + (size_t)nxt.pn * tstep + (size_t)nxt.pk * kchunk : cB;
        for (int t = 0; t < nt; t += 2) {
            const bool last = (t == nt - 2);
            const char* a1 = cA + (size_t)(t + 1) * kstep;
            const char* a2 = last ? nA : cA + (size_t)(t + 2) * kstep; const char* b2 = last ? nB : cB + (size_t)(t + 2) * kstep;
            const char* a3 = a2 + kstep; const char* b3 = b2 + kstep;
            if (last && has_next) S.a_ready(nxt);
            if constexpr (SP2) {
            PG8_LDB(B0, 0, 0); PG8_LDB(B1, 0, 1); PG8_SCHED; PG8_LDA(At, 0, 0); PG8_STAGE(PG8_SA(1, 1), a1 + hstep, voffA);
            PG8_WAIT_V(8); PG8_WAIT_L(0); PG8_BAR; PG8_MMA(0, 0, At, B0); PG8_MMA(0, 1, At, B1); PG8_BAR; PG8_SCHED;
            PG8_LDA(At, 0, 1); PG8_STAGE(PG8_SB(0, 0), b2, voffB); PG8_STAGE(PG8_SB(0, 1), b2 + hstep, voffB); PG8_STAGE(PG8_SA(0, 0), a2, voffA);
            PG8_WAIT_V(8); PG8_WAIT_L(0); PG8_BAR; PG8_MMA(1, 0, At, B0); PG8_MMA(1, 1, At, B1); PG8_BAR; PG8_SCHED;
            PG8_LDB(B0, 1, 0); PG8_LDB(B1, 1, 1); PG8_SCHED; PG8_LDA(At, 1, 0); PG8_STAGE(PG8_SA(0, 1), a2 + hstep, voffA);
            PG8_WAIT_V(8); PG8_WAIT_L(0); PG8_BAR; PG8_MMA(0, 0, At, B0); PG8_MMA(0, 1, At, B1); PG8_BAR; PG8_SCHED;
            PG8_LDA(At, 1, 1); PG8_STAGE(PG8_SB(1, 0), b3, voffB); PG8_STAGE(PG8_SB(1, 1), b3 + hstep, voffB); PG8_STAGE(PG8_SA(1, 0), a3, voffA);
            PG8_WAIT_V(8); PG8_WAIT_L(0); PG8_BAR; PG8_MMA(1, 0, At, B0); PG8_MMA(1, 1, At, B1); PG8_BAR; PG8_SCHED;
            } else {
            PG8_LDB(B0, 0, 0); PG8_SCHED; PG8_LDA(At, 0, 0); PG8_STAGE(PG8_SA(1, 1), a1 + hstep, voffA);
            PG8_WAIT_L(8); PG8_BAR; PG8_WAIT_L(0); PG8_MMA(0, 0, At, B0); PG8_BAR; PG8_SCHED;
            PG8_LDB(B1, 0, 1); PG8_STAGE(PG8_SB(0, 0), b2, voffB);
            PG8_BAR; PG8_WAIT_L(0); PG8_MMA(0, 1, At, B1); PG8_BAR;
            PG8_LDA(At, 0, 1); PG8_STAGE(PG8_SA(0, 0), a2, voffA);
            PG8_BAR; PG8_WAIT_L(0); PG8_MMA(1, 0, At, B0); PG8_BAR; PG8_SCHED;
            PG8_STAGE(PG8_SB(0, 1), b2 + hstep, voffB);
            PG8_WAIT_V(6); PG8_BAR; PG8_MMA(1, 1, At, B1); PG8_BAR;
            PG8_LDB(B0, 1, 0); PG8_SCHED; PG8_LDA(At, 1, 0); PG8_STAGE(PG8_SA(0, 1), a2 + hstep, voffA);
            PG8_WAIT_L(8); PG8_BAR; PG8_WAIT_L(0); PG8_MMA(0, 0, At, B0); PG8_BAR; PG8_SCHED;
            PG8_LDB(B1, 1, 1); PG8_STAGE(PG8_SB(1, 0), b3, voffB);
            PG8_BAR; PG8_WAIT_L(0); PG8_MMA(0, 1, At, B1); PG8_BAR;
            PG8_LDA(At, 1, 1); PG8_STAGE(PG8_SA(1, 0), a3, voffA);
            PG8_BAR; PG8_WAIT_L(0); PG8_MMA(1, 0, At, B0); PG8_BAR; PG8_SCHED;
            PG8_STAGE(PG8_SB(1, 1), b3 + hstep, voffB);
            PG8_WAIT_V(6); PG8_BAR; PG8_MMA(1, 1, At, B1); PG8_BAR;
            }
        }
        if constexpr (ALIGN_EPI) { if (wr == 0) PG8_BAR; }
        if constexpr (!Epi::AFTER_DRAIN) { E(acc, cur, wr, wc, fr, fq); S.done(cur); }
        if (!has_next) break;
#pragma unroll
        for (int a = 0; a < 2; ++a)
#pragma unroll
            for (int b = 0; b < 2; ++b)
#pragma unroll
                for (int m = 0; m < 4; ++m)
#pragma unroll
                    for (int n = 0; n < 2; ++n) acc[a][b][m][n] = (f32x4){0.f, 0.f, 0.f, 0.f};
        cur = nxt; cA = nA; cB = nB; ++ui;
        if constexpr (ALIGN_EPI) { if (wr == 1) PG8_BAR; }
    }
    PG8_WAIT_V(0);
    if constexpr (!ALIGN_EPI) { if (wr == 0) PG8_BAR; }
    PG8_BAR;
    if constexpr (Epi::AFTER_DRAIN) { E.fused(acc, cur, wr, wc, fr, fq, lds, wid, lane); S.done(cur); }
#undef PG8_SA
#undef PG8_SB
#undef PG8_STAGE
#undef PG8_LDA
#undef PG8_LDB
#undef PG8_MMA
#undef PG8_WAIT_V
#undef PG8_WAIT_L
#undef PG8_BAR
#undef PG8_SCHED
}
}

#define LAS __attribute__((address_space(3)))
typedef unsigned short bf16;
typedef unsigned v4u __attribute__((ext_vector_type(4)));
typedef unsigned v2u __attribute__((ext_vector_type(2)));
typedef float f32x4 __attribute__((ext_vector_type(4)));
typedef float f32x16 __attribute__((ext_vector_type(16)));
typedef short bf16x8 __attribute__((ext_vector_type(8)));
typedef short s16x4 __attribute__((ext_vector_type(4)));
typedef float f32x2_t __attribute__((ext_vector_type(2)));
typedef __bf16 bf16x2_t __attribute__((ext_vector_type(2)));

constexpr int DM = 1024, NB = 16, SEQ = 2048, NMETA = 16, LP = NMETA + SEQ, NDB = 32, DSQ = 32, PAST = 2048, NH = 8, HD = 64;
constexpr int AW = 512, CC = 512, CK = 31, DFF = 4096, INC = 2560;
constexpr int MP = NB * LP;
constexpr int MS = NDB * DSQ;
constexpr int MT = MP + MS;
static_assert(MT % 256 == 0 && MP % 256 == 0, "row tiles");
constexpr float ALPHA = 1.189207115002721f;
constexpr float LN_EPS = 1e-5f;
constexpr float QSCALE = 0.125f * 1.4426950408889634f;

constexpr size_t OFF_YP = 0, OFF_YS = (size_t)NB * SEQ * DM, OFF_KP = OFF_YS + (size_t)MS * DM, OFF_VP = OFF_KP + (size_t)MP * AW,
                 OFF_CP = OFF_VP + (size_t)MP * AW, OFF_KS = OFF_CP + (size_t)NB * 30 * CC, OFF_VS = OFF_KS + (size_t)MS * AW, OFF_CS = OFF_VS + (size_t)MS * AW,
                 OUT_TOTAL = OFF_CS + (size_t)NDB * 30 * CC;

constexpr size_t MiB = 1u << 20;
constexpr size_t WS_CTL = 0, CTL_BYTES = 344064, WS_C1 = 32768, WS_C2 = 49152, WS_STAT = 65536;
constexpr size_t CTL_OLD_BYTES = 65536;
constexpr int CW_BAR = 4096;
constexpr size_t WS_WIN = 1 * MiB, WS_WOUT = 6 * MiB, WS_W1 = 8 * MiB, WS_W2 = 16 * MiB;
constexpr size_t WS_ATT = 24 * MiB;
constexpr size_t WS_R = 91 * MiB;
constexpr size_t QSZ = (size_t)MT * 512 * 2;
constexpr size_t WS_XN = 224 * MiB;
constexpr size_t WS_F = 91 * MiB;
constexpr size_t WS_END = WS_F + (size_t)MT * DFF * 2;
static_assert(WS_ATT + (size_t)MT * DM * 2 <= WS_R && WS_R + 4 * QSZ <= WS_XN && WS_R + (size_t)MT * DM * 4 <= WS_XN, "ws map");

constexpr int MAIN_ROWS = 32768;
constexpr int TAIL_ROWS = MT - MAIN_ROWS, TAIL_S = 8;
constexpr size_t WS_PART = 360 * MiB;
constexpr size_t WS_END2 = WS_PART + (size_t)TAIL_S * TAIL_ROWS * DM * 4;
static_assert(WS_END <= WS_PART, "ws map 2");
constexpr size_t WS_X1B = 402 * MiB;
constexpr size_t WS_Y2B = WS_ATT;
constexpr size_t WS_END3 = WS_X1B + (size_t)MT * DM * 2;
static_assert(WS_END2 <= WS_X1B && WS_STAT + (size_t)MT * 8 <= CTL_BYTES && CTL_BYTES <= WS_WIN, "ws map 3");
constexpr int LDS_BYTES = 149504;
constexpr int NTHREADS = 512, NWAVES = 8;

struct Params {
    const float *x_prompt, *x_sample, *cache_k, *cache_v, *state_conv, *meta, *g_in, *b_in, *w_in, *w_dw, *b_dw, *g_conv, *b_conv, *w_out, *g1, *b1, *w_ff1, *w_ff2, *g2, *b2;
    float* out; unsigned char* ws;
};

__device__ __forceinline__ unsigned pk2(float lo, float hi) { f32x2_t v = {lo, hi}; bf16x2_t b = __builtin_convertvector(v, bf16x2_t); return __builtin_bit_cast(unsigned, b); }
__device__ __forceinline__ float bflo(unsigned w) { return __uint_as_float(w << 16); }
__device__ __forceinline__ float bfhi(unsigned w) { return __uint_as_float(w & 0xffff0000u); }
__device__ __forceinline__ float wave_sum(float v) {
#pragma unroll
    for (int o = 1; o < 64; o <<= 1) v += __shfl_xor(v, o);
    return v;
}

__device__ __forceinline__ void transpose_item(const float* W, int K, int N, bf16* WT, int dst_row0, LAS float* scr, int k0, int n0, int lane) {
    { float t[32]; const float* wp = W + (size_t)(k0 + (lane >> 5)) * N + n0 + (lane & 31);
#pragma unroll
      for (int i = 0; i < 32; ++i) t[i] = wp[(size_t)(2 * i) * N];
#pragma unroll
      for (int i = 0; i < 32; ++i) scr[(2 * i + (lane >> 5)) * 33 + (lane & 31)] = t[i]; }
    asm volatile("s_waitcnt lgkmcnt(0)" ::: "memory");
    const int c = lane & 7;
#pragma unroll
    for (int j = 0; j < 4; ++j) { const int n = (lane >> 3) + 8 * j; const LAS float* s = scr + (8 * c) * 33 + n;
        v4u o; o.x = pk2(s[0 * 33], s[1 * 33]); o.y = pk2(s[2 * 33], s[3 * 33]); o.z = pk2(s[4 * 33], s[5 * 33]); o.w = pk2(s[6 * 33], s[7 * 33]);
        *(v4u*)(WT + (size_t)(dst_row0 + n) * K + k0 + 8 * c) = o; }
    asm volatile("s_waitcnt lgkmcnt(0)" ::: "memory");
}
__device__ __forceinline__ void transpose_item_w1(const float* W, int K, int N, bf16* WT, const float* g1, const float* b1, float* c1, float* c2, LAS float* scr, int k0, int n0, int lane) {
    { float t[32]; const float* wp = W + (size_t)(k0 + (lane >> 5)) * N + n0 + (lane & 31);
#pragma unroll
      for (int i = 0; i < 32; ++i) t[i] = wp[(size_t)(2 * i) * N];
#pragma unroll
      for (int i = 0; i < 32; ++i) scr[(2 * i + (lane >> 5)) * 33 + (lane & 31)] = t[i]; }
    asm volatile("s_waitcnt lgkmcnt(0)" ::: "memory");
    const int c = lane & 7;
    const f32x4 ga = *(const f32x4*)(g1 + k0 + 8 * c), gb = *(const f32x4*)(g1 + k0 + 8 * c + 4), ba = *(const f32x4*)(b1 + k0 + 8 * c), bb = *(const f32x4*)(b1 + k0 + 8 * c + 4);
#pragma unroll
    for (int j = 0; j < 4; ++j) { const int n = (lane >> 3) + 8 * j; const LAS float* s = scr + (8 * c) * 33 + n;
        const float w0 = s[0 * 33], w1 = s[1 * 33], w2 = s[2 * 33], w3 = s[3 * 33], w4 = s[4 * 33], w5 = s[5 * 33], w6 = s[6 * 33], w7 = s[7 * 33];
        v4u o; o.x = pk2(w0 * ga[0], w1 * ga[1]); o.y = pk2(w2 * ga[2], w3 * ga[3]); o.z = pk2(w4 * gb[0], w5 * gb[1]); o.w = pk2(w6 * gb[2], w7 * gb[3]);
        *(v4u*)(WT + (size_t)(n0 + n) * K + k0 + 8 * c) = o;
        float r1 = ((bflo(o.x) + bfhi(o.x)) + (bflo(o.y) + bfhi(o.y))) + ((bflo(o.z) + bfhi(o.z)) + (bflo(o.w) + bfhi(o.w)));
        float r2 = ((w0 * ba[0] + w1 * ba[1]) + (w2 * ba[2] + w3 * ba[3])) + ((w4 * bb[0] + w5 * bb[1]) + (w6 * bb[2] + w7 * bb[3]));
        r1 += __shfl_xor(r1, 1); r2 += __shfl_xor(r2, 1); r1 += __shfl_xor(r1, 2); r2 += __shfl_xor(r2, 2); r1 += __shfl_xor(r1, 4); r2 += __shfl_xor(r2, 4);
        if (c == 0) { unsafeAtomicAdd(c1 + n0 + n, r1); unsafeAtomicAdd(c2 + n0 + n, r2); } }
    asm volatile("s_waitcnt lgkmcnt(0)" ::: "memory");
}
__device__ __forceinline__ int win_dst_row(int c) {
    if (c < 1536) return c;
    if (c < 2048) { const int ch = c - 1536; return 1536 + 256 * (ch >> 7) + (ch & 127); }
    const int ch = c - 2048; return 1536 + 256 * (ch >> 7) + 128 + (ch & 127);
}
__device__ __forceinline__ void load_row_f32(const float* xrow, int lane, f32x4 (&v)[4]) {
#pragma unroll
    for (int j = 0; j < 4; ++j) v[j] = ((const f32x4*)xrow)[lane + 64 * j];
}
__device__ __forceinline__ void load_row_bf16(const bf16* xrow, int lane, f32x4 (&v)[4]) {
#pragma unroll
    for (int j = 0; j < 4; ++j) { const v2u rw = ((const v2u*)xrow)[lane + 64 * j]; v[j][0] = bflo(rw.x); v[j][1] = bfhi(rw.x); v[j][2] = bflo(rw.y); v[j][3] = bfhi(rw.y); }
}
__device__ __forceinline__ void add_partials(const float* part, int lane, f32x4 (&v)[4]) {
#pragma unroll
    for (int c = 0; c < TAIL_S; ++c)
#pragma unroll
        for (int j = 0; j < 4; ++j) v[j] += ((const f32x4*)(part + (size_t)c * TAIL_ROWS * DM))[lane + 64 * j];
}
__device__ __forceinline__ void affine_row(float mean, float rstd, const float* g, const float* b, int lane, f32x4 (&v)[4]) {
#pragma unroll
    for (int j = 0; j < 4; ++j) { const f32x4 gg = ((const f32x4*)g)[lane + 64 * j], bb = ((const f32x4*)b)[lane + 64 * j]; v[j] = (v[j] - mean) * rstd * gg + bb; }
}
__device__ __forceinline__ void ln_apply(const float* g, const float* b, int lane, f32x4 (&v)[4]) {
    float s = 0.f;
#pragma unroll
    for (int j = 0; j < 4; ++j) s += (v[j].x + v[j].y) + (v[j].z + v[j].w);
    const float mean = wave_sum(s) * (1.f / DM); float s2 = 0.f;
#pragma unroll
    for (int j = 0; j < 4; ++j) { const f32x4 d = v[j] - mean; s2 += (d.x * d.x + d.y * d.y) + (d.z * d.z + d.w * d.w); }
    const float rstd = 1.f / sqrtf(wave_sum(s2) * (1.f / DM) + LN_EPS);
    affine_row(mean, rstd, g, b, lane, v);
}
__device__ __forceinline__ void stat_mr(const float* stat, int row, float& mean, float& rstd) {
    const f32x2_t st = *(const f32x2_t*)(stat + 2 * (size_t)row); mean = st.x * (1.f / DM); rstd = __builtin_amdgcn_rsqf(fmaxf(st.y * (1.f / DM) - mean * mean, 0.f) + LN_EPS);
}
__device__ __forceinline__ void store_row_bf16(bf16* orow, int lane, const f32x4 (&v)[4]) {
    v2u* o8 = (v2u*)orow + lane;
#pragma unroll
    for (int j = 0; j < 4; ++j) { v2u w; w.x = pk2(v[j].x, v[j].y); w.y = pk2(v[j].z, v[j].w); o8[64 * j] = w; }
}

__device__ __forceinline__ const float* ln_in_src(const Params& P, int m) {
    if (m < MP) { const int b = m / LP, t = m - b * LP; return (t < NMETA) ? P.meta + (size_t)t * DM : P.x_prompt + ((size_t)b * SEQ + (t - NMETA)) * DM; }
    return P.x_sample + (size_t)(m - MP) * DM;
}
__device__ __forceinline__ void ln_in_pair(const Params& P, bf16* XN, int m, int m1, bool has1, int lane) {
    f32x4 v0[4], v1[4];
    load_row_f32(ln_in_src(P, m), lane, v0);
    if (has1) load_row_f32(ln_in_src(P, m1), lane, v1);
    ln_apply(P.g_in, P.b_in, lane, v0); store_row_bf16(XN + (size_t)m * DM, lane, v0);
    if (has1) { ln_apply(P.g_in, P.b_in, lane, v1); store_row_bf16(XN + (size_t)m1 * DM, lane, v1); }
}
__device__ __forceinline__ void p0a_prologue(const Params& P, LAS unsigned char* lds, int wave, int lane) {
    LAS float* scr = (LAS float*)(lds + wave * 16384);
    const int gw = blockIdx.x * NWAVES + wave, NGW = gridDim.x * NWAVES;
    bf16* WinT = (bf16*)(P.ws + WS_WIN); bf16* XN = (bf16*)(P.ws + WS_XN);
    constexpr int I_IN = (DM / 64) * (INC / 32);
    for (int it = gw; it < I_IN; it += NGW) { const int nblk = INC / 32, kb = it / nblk, nb = it % nblk; transpose_item(P.w_in, DM, INC, WinT, win_dst_row(32 * nb), scr, 64 * kb, 32 * nb, lane); }
    for (int m = MAIN_ROWS + gw; m < MT; m += NGW) ln_in_pair(P, XN, m, m, false, lane);
}
constexpr int P0B_LN = MAIN_ROWS / 16, P0B_OUT = (DM / 64) * (DM / 32), P0B_1 = (DM / 64) * (DFF / 32), P0B_2 = (DFF / 64) * (DM / 32), P0B_ITEMS = P0B_LN + P0B_OUT + P0B_1 + P0B_2;
__device__ __forceinline__ void p0b_queue(const Params& P, LAS unsigned char* lds, unsigned* ctr, int wave, int lane) {
    LAS float* scr = (LAS float*)(lds + wave * 16384);
    bf16* WoutT = (bf16*)(P.ws + WS_WOUT); bf16* W1T = (bf16*)(P.ws + WS_W1); bf16* W2T = (bf16*)(P.ws + WS_W2); bf16* XN = (bf16*)(P.ws + WS_XN);
    LAS int* bc = (LAS int*)(lds + LDS_BYTES - 512);
    for (;;) {
        if (threadIdx.x == 0) bc[0] = (int)atomicAdd(ctr, 1u);
        __syncthreads();
        const int grp = bc[0];
        __syncthreads();
        if (grp * 8 >= P0B_ITEMS) break;
        int r = grp * 8 + wave;
        if (r < P0B_LN) {
#pragma unroll 1
            for (int k = 0; k < 8; ++k) ln_in_pair(P, XN, 16 * r + 2 * k, 16 * r + 2 * k + 1, true, lane);
            continue; } r -= P0B_LN;
        if (r < P0B_OUT) { const int nblk = DM / 32, kb = r / nblk, nb = r % nblk; transpose_item(P.w_out, DM, DM, WoutT, 32 * nb, scr, 64 * kb, 32 * nb, lane); continue; } r -= P0B_OUT;
        if (r < P0B_1) { const int nblk = DFF / 32, kb = r / nblk, nb = r % nblk; transpose_item_w1(P.w_ff1, DM, DFF, W1T, P.g1, P.b1, (float*)(P.ws + WS_C1), (float*)(P.ws + WS_C2), scr, 64 * kb, 32 * nb, lane); continue; } r -= P0B_1;
        { const int nblk = DM / 32, kb = r / nblk, nb = r % nblk; transpose_item(P.w_ff2, DFF, DM, W2T, 32 * nb, scr, 64 * kb, 32 * nb, lane); }
    }
}

using pg8::Unit;
struct EpiInProj {
    static constexpr bool PERM = true, AFTER_DRAIN = false;
    bf16 *Q, *K, *V, *U; float* out;
    __device__ __forceinline__ void operator()(const f32x4 (&acc)[2][2][4][2], const Unit& u, int wr, int wc, int fr, int fq) const {
        const int pn = u.pn, rbase = u.pm * 256 + wr * 64 + fr;
        const bool prompt = (u.pm * 256) < MP;
        if (pn < 6) {
            const int seg = pn >> 1;
            bf16* B = Q + (size_t)seg * ((size_t)MT * 512);
            const float sc = seg == 0 ? QSCALE : 1.f;
            const int colt = (pn & 1) * 256 + wc * 32 + 8 * fq;
            float* fo = out + (prompt ? OFF_KP + (size_t)(seg - 1) * (OFF_VP - OFF_KP) : OFF_KS + (size_t)(seg - 1) * (OFF_VS - OFF_KS));
#pragma unroll
            for (int ai = 0; ai < 2; ++ai)
#pragma unroll
                for (int m = 0; m < 4; ++m) { const int row = rbase + ai * 128 + m * 16; const int frow = prompt ? row : row - MP;
#pragma unroll
                    for (int bj = 0; bj < 2; ++bj) { const int col = colt + bj * 128; f32x4 v0 = acc[ai][bj][m][0], v1 = acc[ai][bj][m][1]; if (seg == 0) { v0 = v0 * sc; v1 = v1 * sc; }
                        v4u w; w.x = pk2(v0[0], v0[1]); w.y = pk2(v0[2], v0[3]); w.z = pk2(v1[0], v1[1]); w.w = pk2(v1[2], v1[3]);
                        *(v4u*)(B + (size_t)row * 512 + col) = w;
                        if (seg > 0) { float* p = fo + (size_t)frow * 512 + col; __builtin_nontemporal_store(v0, (f32x4*)p); __builtin_nontemporal_store(v1, (f32x4*)(p + 4)); } } }
        } else {
            const int ch0 = (pn - 6) * 128 + wc * 32 + 8 * fq;
#pragma unroll
            for (int ai = 0; ai < 2; ++ai)
#pragma unroll
                for (int m = 0; m < 4; ++m) { const int row = rbase + ai * 128 + m * 16;
                    f32x4 uu[2];
#pragma unroll
                    for (int n = 0; n < 2; ++n) { const f32x4 a = acc[ai][0][m][n], g = acc[ai][1][m][n];
#pragma unroll
                        for (int e = 0; e < 4; ++e) uu[n][e] = a[e] * __builtin_amdgcn_rcpf(1.f + __expf(-g[e])); }
                    v4u w; w.x = pk2(uu[0][0], uu[0][1]); w.y = pk2(uu[0][2], uu[0][3]); w.z = pk2(uu[1][0], uu[1][1]); w.w = pk2(uu[1][2], uu[1][3]);
                    *(v4u*)(U + (size_t)row * 512 + ch0) = w;
                    if (prompt) { const int b = row / LP, t = row - b * LP;
                        if (t >= LP - 30) { float* p = out + OFF_CP + ((size_t)(b * 30 + t - (LP - 30))) * CC + ch0; *(f32x4*)p = uu[0]; *(f32x4*)(p + 4) = uu[1]; } }
                    else { const int rs = row - MP, db = rs >> 5, i = rs & 31;
                        if (i >= 2) { float* p = out + OFF_CS + ((size_t)(db * 30 + i - 2)) * CC + ch0; *(f32x4*)p = uu[0]; *(f32x4*)(p + 4) = uu[1]; } } }
        }
    }
};
struct EpiX1 {
    static constexpr bool PERM = true, AFTER_DRAIN = false;
    const bf16* res; bf16* dst; float* stat;
    __device__ __forceinline__ void operator()(const f32x4 (&acc)[2][2][4][2], const Unit& u, int wr, int wc, int fr, int fq) const {
        const int rbase = u.pm * 256 + wr * 64 + fr, cbase = u.pn * 256 + wc * 32 + 8 * fq;
#pragma unroll
        for (int ai = 0; ai < 2; ++ai)
#pragma unroll
            for (int m = 0; m < 4; ++m) { const int row = rbase + ai * 128 + m * 16; const size_t ro = (size_t)row * DM;
                float s = 0.f, q = 0.f;
#pragma unroll
                for (int bj = 0; bj < 2; ++bj) { const int c = cbase + bj * 128; const v4u rw = *(const v4u*)(res + ro + c);
                    const f32x4 v0 = acc[ai][bj][m][0], v1 = acc[ai][bj][m][1];
                    v4u w; w.x = pk2(ALPHA * bflo(rw.x) + v0[0], ALPHA * bfhi(rw.x) + v0[1]); w.y = pk2(ALPHA * bflo(rw.y) + v0[2], ALPHA * bfhi(rw.y) + v0[3]);
                    w.z = pk2(ALPHA * bflo(rw.z) + v1[0], ALPHA * bfhi(rw.z) + v1[1]); w.w = pk2(ALPHA * bflo(rw.w) + v1[2], ALPHA * bfhi(rw.w) + v1[3]);
                    *(v4u*)(dst + ro + c) = w;
#pragma unroll
                    for (int e = 0; e < 4; ++e) { const float a = bflo(w[e]), b = bfhi(w[e]); s += a + b; q += a * a + b * b; } }
                s += __shfl_xor(s, 16); q += __shfl_xor(q, 16); s += __shfl_xor(s, 32); q += __shfl_xor(q, 32);
                if (fq == 0) { unsafeAtomicAdd(stat + 2 * (size_t)row, s); unsafeAtomicAdd(stat + 2 * (size_t)row + 1, q); } }
    }
};
struct EpiFF1 {
    static constexpr bool PERM = true, AFTER_DRAIN = false;
    bf16* F; const float* stat; const float* c1; const float* c2;
    __device__ __forceinline__ void operator()(const f32x4 (&acc)[2][2][4][2], const Unit& u, int wr, int wc, int fr, int fq) const {
        const int rbase = u.pm * 256 + wr * 64 + fr, cbase = u.pn * 256 + wc * 32 + 8 * fq;
        f32x4 c1v[2][2], c2v[2][2];
#pragma unroll
        for (int bj = 0; bj < 2; ++bj)
#pragma unroll
            for (int n = 0; n < 2; ++n) { c1v[bj][n] = *(const f32x4*)(c1 + cbase + bj * 128 + 4 * n); c2v[bj][n] = *(const f32x4*)(c2 + cbase + bj * 128 + 4 * n); }
#pragma unroll
        for (int ai = 0; ai < 2; ++ai)
#pragma unroll
            for (int m = 0; m < 4; ++m) { const int row = rbase + ai * 128 + m * 16; bf16* rowp = F + (size_t)row * DFF + cbase;
                float mean, rstd; stat_mr(stat, row, mean, rstd);
#pragma unroll
                for (int bj = 0; bj < 2; ++bj) { f32x4 v0 = (acc[ai][bj][m][0] - mean * c1v[bj][0]) * rstd + c2v[bj][0], v1 = (acc[ai][bj][m][1] - mean * c1v[bj][1]) * rstd + c2v[bj][1];
#pragma unroll
                    for (int e = 0; e < 4; ++e) { const float a = fmaxf(v0[e], 0.f), b = fmaxf(v1[e], 0.f); v0[e] = a * a; v1[e] = b * b; }
                    v4u w; w.x = pk2(v0[0], v0[1]); w.y = pk2(v0[2], v0[3]); w.z = pk2(v1[0], v1[1]); w.w = pk2(v1[2], v1[3]);
                    *(v4u*)(rowp + bj * 128) = w; } }
    }
};
struct EpiY2 {
    static constexpr bool PERM = true, AFTER_DRAIN = false;
    const bf16* x1b; bf16* dst; const float* stat; const float* g1; const float* b1;
    __device__ __forceinline__ void operator()(const f32x4 (&acc)[2][2][4][2], const Unit& u, int wr, int wc, int fr, int fq) const {
        const int rbase = u.pm * 256 + wr * 64 + fr, cbase = u.pn * 256 + wc * 32 + 8 * fq;
        f32x4 gv[2][2], bv[2][2];
#pragma unroll
        for (int bj = 0; bj < 2; ++bj)
#pragma unroll
            for (int n = 0; n < 2; ++n) { gv[bj][n] = *(const f32x4*)(g1 + cbase + bj * 128 + 4 * n) * ALPHA; bv[bj][n] = *(const f32x4*)(b1 + cbase + bj * 128 + 4 * n) * ALPHA; }
#pragma unroll
        for (int ai = 0; ai < 2; ++ai)
#pragma unroll
            for (int m = 0; m < 4; ++m) { const int row = rbase + ai * 128 + m * 16; const size_t ro = (size_t)row * DM;
                const int t = row % LP;
                if (t >= NMETA) {
                    float mean, rstd; stat_mr(stat, row, mean, rstd);
#pragma unroll
                    for (int bj = 0; bj < 2; ++bj) { const int c = cbase + bj * 128; const v4u rw = *(const v4u*)(x1b + ro + c);
                        f32x4 x0, x1; x0[0] = bflo(rw.x); x0[1] = bfhi(rw.x); x0[2] = bflo(rw.y); x0[3] = bfhi(rw.y); x1[0] = bflo(rw.z); x1[1] = bfhi(rw.z); x1[2] = bflo(rw.w); x1[3] = bfhi(rw.w);
                        const f32x4 o0 = (x0 - mean) * rstd * gv[bj][0] + bv[bj][0] + acc[ai][bj][m][0], o1 = (x1 - mean) * rstd * gv[bj][1] + bv[bj][1] + acc[ai][bj][m][1];
                        v4u w; w.x = pk2(o0[0], o0[1]); w.y = pk2(o0[2], o0[3]); w.z = pk2(o1[0], o1[1]); w.w = pk2(o1[2], o1[3]);
                        *(v4u*)(dst + ro + c) = w; } } }
    }
};
struct EpiPart {
    static constexpr bool PERM = false, AFTER_DRAIN = false;
    float* part;
    __device__ __forceinline__ void operator()(const f32x4 (&acc)[2][2][4][2], const Unit& u, int wr, int wc, int fr, int fq) const {
        const int rbase = u.pm * 256 - MAIN_ROWS + wr * 64 + fr, cbase = u.pn * 256 + wc * 32 + 4 * fq;
        float* pb = part + (size_t)u.pk * TAIL_ROWS * DM;
#pragma unroll
        for (int ai = 0; ai < 2; ++ai)
#pragma unroll
            for (int m = 0; m < 4; ++m) { const size_t ro = (size_t)(rbase + ai * 128 + m * 16) * DM;
#pragma unroll
                for (int bj = 0; bj < 2; ++bj)
#pragma unroll
                    for (int n = 0; n < 2; ++n) *(f32x4*)(pb + ro + cbase + bj * 128 + n * 16) = acc[ai][bj][m][n]; }
    }
};
constexpr int KS = 144;
constexpr int WAVE_LDS = 2 * 64 * KS;
constexpr int ATT_PER_HEAD = NDB + NB * 65;
constexpr int N_ATT_ITEMS = NH * ATT_PER_HEAD;
constexpr float EXIT_THR = 160.f;
#define MFMA32(a, b, c) __builtin_amdgcn_mfma_f32_32x32x16_bf16((a), (b), (c), 0, 0, 0)
typedef short v4i16_t __attribute__((ext_vector_type(4)));
__device__ __forceinline__ s16x4 vtr(const LAS unsigned char* p) { return __builtin_bit_cast(s16x4, __builtin_amdgcn_ds_read_tr16_b64_v4i16((LAS v4i16_t*)p)); }
__device__ __forceinline__ int clampi(int v, int lo, int hi) { return v < lo ? lo : (v > hi ? hi : v); }

__device__ __forceinline__ void attn_tile(const LAS unsigned char* Kl, const LAS unsigned char* Vl, const bf16x8 (&qf)[4], float& carry, f32x16 (&o)[2], bool needmask, int k0, int p0, int lane) {
    const int r32 = lane & 31, hi = lane >> 5;
    f32x16 z0, z1;
#pragma unroll
    for (int r = 0; r < 16; ++r) { z0[r] = 0.f; z1[r] = 0.f; }
    const LAS unsigned char* kp = Kl + r32 * KS + hi * 16;
#pragma unroll
    for (int d0 = 0; d0 < 4; ++d0) {
        const bf16x8 a0 = *(const LAS bf16x8*)(kp + d0 * 32);
        const bf16x8 a1 = *(const LAS bf16x8*)(kp + 32 * KS + d0 * 32);
        z0 = MFMA32(a0, qf[d0], z0); z1 = MFMA32(a1, qf[d0], z1);
    }
    if (needmask) {
        const int q = p0 + r32;
#pragma unroll
        for (int r = 0; r < 16; ++r) { const int s = k0 + 8 * (r >> 2) + 4 * hi + (r & 3);
            if (!(s < q && s >= 0)) z0[r] = -INFINITY;
            if (!(s + 32 < q && s + 32 >= 0)) z1[r] = -INFINITY; }
    }
    f32x16 s0, s1;
#pragma unroll
    for (int r = 0; r < 16; ++r) {
        s0[r] = fmaxf(z0[r], 0.f) + __builtin_amdgcn_logf(1.f + __builtin_amdgcn_exp2f(-fabsf(z0[r])));
        s1[r] = fmaxf(z1[r], 0.f) + __builtin_amdgcn_logf(1.f + __builtin_amdgcn_exp2f(-fabsf(z1[r])));
    }
#pragma unroll
    for (int g = 0; g < 4; ++g) {
        s0[4 * g + 2] += s0[4 * g + 3]; s0[4 * g + 1] += s0[4 * g + 2]; s0[4 * g] += s0[4 * g + 1];
        s1[4 * g + 2] += s1[4 * g + 3]; s1[4 * g + 1] += s1[4 * g + 2]; s1[4 * g] += s1[4 * g + 1];
    }
    float lo[8], hh[8];
#pragma unroll
    for (int g = 0; g < 8; ++g) { const float gs = g < 4 ? s0[4 * g] : s1[4 * (g - 4)];
        auto rr = __builtin_amdgcn_permlane32_swap(__float_as_uint(gs), __float_as_uint(gs), false, false);
        lo[g] = __uint_as_float(rr[0]); hh[g] = __uint_as_float(rr[1]); }
    float base[8]; float run = carry;
#pragma unroll
    for (int g = 7; g >= 0; --g) { base[g] = run + (hi == 0 ? hh[g] : 0.f); run += lo[g] + hh[g]; }
    carry = run;
#pragma unroll
    for (int r = 0; r < 16; ++r) {
        z0[r] = __builtin_amdgcn_exp2f(z0[r] - (s0[r] + base[r >> 2]));
        z1[r] = __builtin_amdgcn_exp2f(z1[r] - (s1[r] + base[4 + (r >> 2)]));
    }
    const LAS unsigned char* vp = Vl + (4 * hi + ((lane & 15) >> 2)) * KS + ((lane >> 4) & 1) * 32 + (lane & 3) * 8;
#pragma unroll
    for (int blk = 0; blk < 2; ++blk)
#pragma unroll
        for (int s = 0; s < 2; ++s) {
            v4u pw;
            if (blk == 0) { pw.x = pk2(z0[8 * s], z0[8 * s + 1]); pw.y = pk2(z0[8 * s + 2], z0[8 * s + 3]); pw.z = pk2(z0[8 * s + 4], z0[8 * s + 5]); pw.w = pk2(z0[8 * s + 6], z0[8 * s + 7]); }
            else          { pw.x = pk2(z1[8 * s], z1[8 * s + 1]); pw.y = pk2(z1[8 * s + 2], z1[8 * s + 3]); pw.z = pk2(z1[8 * s + 4], z1[8 * s + 5]); pw.w = pk2(z1[8 * s + 6], z1[8 * s + 7]); }
            const bf16x8 pa = __builtin_bit_cast(bf16x8, pw);
#pragma unroll
            for (int db = 0; db < 2; ++db) {
                const LAS unsigned char* vq = vp + (blk * 32 + 16 * s) * KS + db * 64;
                const s16x4 l4 = vtr(vq), h4 = vtr(vq + 8 * KS);
                const bf16x8 vb = __builtin_shufflevector(l4, h4, 0, 1, 2, 3, 4, 5, 6, 7);
                o[db] = MFMA32(pa, vb, o[db]);
            }
        }
}

__device__ __forceinline__ void attn_item(int item, const Params& P, LAS unsigned char* wl, int lane) {
    const int r32 = lane & 31, hi = lane >> 5;
    const bf16* Qb = (const bf16*)(P.ws + WS_R); const bf16* Kb = (const bf16*)(P.ws + WS_R + QSZ); const bf16* Vb = (const bf16*)(P.ws + WS_R + 2 * QSZ);
    bf16* ATT = (bf16*)(P.ws + WS_ATT);
    LAS unsigned char* Kl = wl; LAS unsigned char* Vl = wl + 64 * KS;
    const int hidx = item / ATT_PER_HEAD, local = item - hidx * ATT_PER_HEAD;
    const bool sample = local < NDB;
    int p0, seqrow0, lmax, ntile, db = 0;
    if (sample) { db = local; p0 = 0; seqrow0 = MP + db * DSQ; lmax = DSQ - 1; ntile = 33; }
    else { const int j = local - NDB, b = j / 65, i = 63 - (j - b * 65); p0 = NMETA + 32 * i; seqrow0 = b * LP; lmax = LP - 1; ntile = (p0 + 31) / 64 + 1; }
    bf16x8 qf[4];
    { const size_t qrow = (size_t)(seqrow0 + clampi(p0 + r32, 0, lmax));
#pragma unroll
      for (int d0 = 0; d0 < 4; ++d0) qf[d0] = *(const bf16x8*)(Qb + qrow * 512 + hidx * 64 + d0 * 16 + hi * 8); }
    f32x16 o[2];
#pragma unroll
    for (int r = 0; r < 16; ++r) { o[0][r] = 0.f; o[1][r] = 0.f; }
    float carry = 0.f;
    const int key_l = lane >> 3, ch = lane & 7;
    const int kfirst = sample ? 0 : p0 - 32;
    v4u kreg[8], vreg[8];
#define LOAD_BF16_TILE(k0_) do { _Pragma("unroll") for (int it = 0; it < 8; ++it) { const size_t row = (size_t)(seqrow0 + clampi((k0_) + 8 * it + key_l, 0, lmax)); \
        kreg[it] = *(const v4u*)(Kb + row * 512 + hidx * 64 + ch * 8); vreg[it] = *(const v4u*)(Vb + row * 512 + hidx * 64 + ch * 8); } } while (0)
#define STORE_TILE() do { _Pragma("unroll") for (int it = 0; it < 8; ++it) { *(LAS v4u*)(Kl + (8 * it + key_l) * KS + ch * 16) = kreg[it]; *(LAS v4u*)(Vl + (8 * it + key_l) * KS + ch * 16) = vreg[it]; } } while (0)
    LOAD_BF16_TILE(kfirst);
    STORE_TILE();
    if (!sample) {
        for (int t = 0; t < ntile; ++t) {
            const int k0 = kfirst - 64 * t;
            if (t + 1 < ntile) LOAD_BF16_TILE(k0 - 64);
            asm volatile("s_waitcnt lgkmcnt(0)" ::: "memory");
            attn_tile(Kl, Vl, qf, carry, o, (k0 < 0) || (k0 + 63 >= p0), k0, p0, lane);
            asm volatile("s_waitcnt lgkmcnt(0)" ::: "memory");
            if (__all(carry > EXIT_THR)) break;
            if (t + 1 < ntile) STORE_TILE();
        }
    } else {
        asm volatile("s_waitcnt lgkmcnt(0)" ::: "memory");
        attn_tile(Kl, Vl, qf, carry, o, true, 0, 0, lane);
        asm volatile("s_waitcnt lgkmcnt(0)" ::: "memory");
        for (int kt = 31; kt >= 0; --kt) {
            if (__all(carry > EXIT_THR)) break;
            const float* ck = P.cache_k + ((size_t)(db * PAST + 64 * kt + key_l) * 512 + hidx * 64 + ch * 8);
            const float* cv = P.cache_v + ((size_t)(db * PAST + 64 * kt + key_l) * 512 + hidx * 64 + ch * 8);
#pragma unroll
            for (int it = 0; it < 8; ++it) { const f32x4 a = *(const f32x4*)(ck + (size_t)it * 8 * 512), b = *(const f32x4*)(ck + (size_t)it * 8 * 512 + 4);
                kreg[it].x = pk2(a[0], a[1]); kreg[it].y = pk2(a[2], a[3]); kreg[it].z = pk2(b[0], b[1]); kreg[it].w = pk2(b[2], b[3]); }
#pragma unroll
            for (int it = 0; it < 8; ++it) { const f32x4 a = *(const f32x4*)(cv + (size_t)it * 8 * 512), b = *(const f32x4*)(cv + (size_t)it * 8 * 512 + 4);
                vreg[it].x = pk2(a[0], a[1]); vreg[it].y = pk2(a[2], a[3]); vreg[it].z = pk2(b[0], b[1]); vreg[it].w = pk2(b[2], b[3]); }
            STORE_TILE();
            asm volatile("s_waitcnt lgkmcnt(0)" ::: "memory");
            attn_tile(Kl, Vl, qf, carry, o, false, 0, 0, lane);
            asm volatile("s_waitcnt lgkmcnt(0)" ::: "memory");
        }
    }
#undef LOAD_BF16_TILE
#undef STORE_TILE
#pragma unroll
    for (int r = 0; r < 16; ++r) { const int q = (r & 3) + 8 * (r >> 2) + 4 * hi, p = p0 + q;
        if (p >= 0) { bf16* dst = ATT + (size_t)(seqrow0 + p) * DM + hidx * 64 + r32;
            dst[0] = (bf16)(pk2(o[0][r], 0.f) & 0xffffu); dst[32] = (bf16)(pk2(o[1][r], 0.f) & 0xffffu); } }
}

constexpr int N_CONV_ITEMS = NB * 65 + NDB;
constexpr int CV_XS = 0, CV_C = 62 * 1024;
struct ConvItem { int seqrow0, t0, tlen, db; bool sample; };
__device__ __forceinline__ ConvItem conv_decode(int item) {
    ConvItem c; c.sample = item >= NB * 65; c.db = 0;
    if (c.sample) { c.db = item - NB * 65; c.seqrow0 = MP + c.db * DSQ; c.t0 = 0; c.tlen = DSQ; }
    else { const int b = item / 65, tt = item - b * 65; c.seqrow0 = b * LP; c.t0 = 32 * tt; c.tlen = LP; }
    return c;
}
__device__ __forceinline__ void conv_load(const ConvItem& ci, const Params& P, int tid, v4u (&st)[8]) {
    const bf16* Ub = (const bf16*)(P.ws + WS_R + 3 * QSZ);
#pragma unroll
    for (int i = 0; i < 8; ++i) { const int c = tid + NTHREADS * i, x = c >> 6, c8 = c & 63, t = ci.t0 - 30 + x;
        v4u w = {0u, 0u, 0u, 0u};
        if (x < 62) {
            if (t >= 0) { if (t < ci.tlen) w = *(const v4u*)(Ub + (size_t)(ci.seqrow0 + t) * 512 + c8 * 8); }
            else if (ci.sample) { const float* sp = P.state_conv + ((size_t)(ci.db * 30 + x)) * CC + c8 * 8; const f32x4 a = *(const f32x4*)sp, b = *(const f32x4*)(sp + 4);
                w.x = pk2(a[0], a[1]); w.y = pk2(a[2], a[3]); w.z = pk2(b[0], b[1]); w.w = pk2(b[2], b[3]); } }
        st[i] = w; }
}
__device__ __forceinline__ void conv_store(LAS unsigned char* lds, int tid, const v4u (&st)[8]) {
#pragma unroll
    for (int i = 0; i < 8; ++i) { const int c = tid + NTHREADS * i, x = c >> 6, c8 = c & 63; if (x < 62) *(LAS v4u*)(lds + CV_XS + x * 1024 + c8 * 16) = st[i]; }
}
__device__ __forceinline__ void conv_phase(const Params& P, LAS unsigned char* lds, unsigned* ctr, int tid, int wave, int lane) {
    bf16* ATT = (bf16*)(P.ws + WS_ATT);
    LAS int* bc = (LAS int*)(lds + LDS_BYTES - 512);
    float wj[CK];
#pragma unroll
    for (int j = 0; j < CK; ++j) wj[j] = P.w_dw[j * CC + tid];
    const float bias = P.b_dw[tid];
    const f32x4 gc0 = *(const f32x4*)(P.g_conv + lane * 8), gc1 = *(const f32x4*)(P.g_conv + lane * 8 + 4), bc0 = *(const f32x4*)(P.b_conv + lane * 8), bc1 = *(const f32x4*)(P.b_conv + lane * 8 + 4);
    if (tid == 0) { bc[0] = (int)atomicAdd(ctr, 1u); bc[1] = (int)atomicAdd(ctr, 1u); }
    __syncthreads();
    int cur = bc[0], nxt = bc[1];
    v4u st[8];
    if (cur < N_CONV_ITEMS) { const ConvItem ci = conv_decode(cur); conv_load(ci, P, tid, st); conv_store(lds, tid, st); }
    __syncthreads();
    const LAS bf16* xs = (const LAS bf16*)(lds + CV_XS) + tid;
    LAS float* cbuf = (LAS float*)(lds + CV_C) + tid;
    while (cur < N_CONV_ITEMS) {
        const ConvItem ci = conv_decode(cur);
        if (tid == 0) bc[2] = (int)atomicAdd(ctr, 1u);
        if (nxt < N_CONV_ITEMS) { const ConvItem cn = conv_decode(nxt); conv_load(cn, P, tid, st); }
#pragma unroll 1
        for (int blk = 0; blk < 4; ++blk) {
            float acc[8];
#pragma unroll
            for (int oo = 0; oo < 8; ++oo) acc[oo] = bias;
#pragma unroll
            for (int x = 0; x < 38; ++x) { const float v = __uint_as_float((unsigned)xs[(8 * blk + x) * 512] << 16);
#pragma unroll
                for (int oo = 0; oo < 8; ++oo) { const int j = x - oo; if (j >= 0 && j < CK) acc[oo] += wj[j] * v; } }
#pragma unroll
            for (int oo = 0; oo < 8; ++oo) cbuf[(8 * blk + oo) * 512] = acc[oo];
        }
        __syncthreads();
        const int nn = bc[2];
        if (nxt < N_CONV_ITEMS) conv_store(lds, tid, st);
        {
            f32x4 a[4], b[4]; float s[4], q[4];
#pragma unroll
            for (int k = 0; k < 4; ++k) { const LAS float* cr = (const LAS float*)(lds + CV_C) + (wave + 8 * k) * 512 + lane * 8; a[k] = *(const LAS f32x4*)cr; b[k] = *(const LAS f32x4*)(cr + 4);
                s[k] = ((a[k][0] + a[k][1]) + (a[k][2] + a[k][3])) + ((b[k][0] + b[k][1]) + (b[k][2] + b[k][3])); }
#pragma unroll
            for (int o = 1; o < 64; o <<= 1) {
#pragma unroll
                for (int k = 0; k < 4; ++k) s[k] += __shfl_xor(s[k], o); }
#pragma unroll
            for (int k = 0; k < 4; ++k) { const float mean = s[k] * (1.f / CC); a[k] = a[k] - mean; b[k] = b[k] - mean;
                q[k] = ((a[k][0] * a[k][0] + a[k][1] * a[k][1]) + (a[k][2] * a[k][2] + a[k][3] * a[k][3])) + ((b[k][0] * b[k][0] + b[k][1] * b[k][1]) + (b[k][2] * b[k][2] + b[k][3] * b[k][3])); }
#pragma unroll
            for (int o = 1; o < 64; o <<= 1) {
#pragma unroll
                for (int k = 0; k < 4; ++k) q[k] += __shfl_xor(q[k], o); }
#pragma unroll
            for (int k = 0; k < 4; ++k) { const int t = ci.t0 + wave + 8 * k;
                if (t < ci.tlen) {
                    const float rstd = 1.f / sqrtf(q[k] * (1.f / CC) + LN_EPS);
                    f32x4 x = a[k] * rstd * gc0 + bc0, y = b[k] * rstd * gc1 + bc1;
#pragma unroll
                    for (int e = 0; e < 4; ++e) { x[e] = x[e] * __builtin_amdgcn_rcpf(1.f + __expf(-x[e])); y[e] = y[e] * __builtin_amdgcn_rcpf(1.f + __expf(-y[e])); }
                    v4u w; w.x = pk2(x[0], x[1]); w.y = pk2(x[2], x[3]); w.z = pk2(y[0], y[1]); w.w = pk2(y[2], y[3]);
                    *(v4u*)(ATT + (size_t)(ci.seqrow0 + t) * DM + AW + lane * 8) = w; } }
        }
        __syncthreads();
        cur = nxt; nxt = nn;
    }
}

#define XB_TMO      128
#define XB_XCNT(j)  (256  + 64 * (j))
#define XB_XSUB(j)  (1280 + 64 * (j))
#define XB_XGEN(j)  (2304 + 64 * (j))
#define XB_TOP      3328
#define XB_TOPGEN   3392
#define XCD_BAR_WORDS 3456
#define XB_SPIN_CAP (1u << 18)

__device__ __forceinline__ unsigned xb_ld(unsigned* p)              { return __hip_atomic_load(p, __ATOMIC_RELAXED, __HIP_MEMORY_SCOPE_AGENT); }
__device__ __forceinline__ unsigned xb_add(unsigned* p, unsigned v) { return __hip_atomic_fetch_add(p, v, __ATOMIC_RELAXED, __HIP_MEMORY_SCOPE_AGENT); }
__device__ __forceinline__ unsigned xb_xcc_id() { return (unsigned)__builtin_amdgcn_s_getreg((3 << 11) | 20) & 0xFu; }
#define XB_SPIN(cond, bar) do { unsigned _sp = 0; while (cond) { __builtin_amdgcn_s_sleep(1); \
    if ((++_sp & 255u) == 0u) { if (xb_ld(&(bar)[XB_TMO])) break; if (_sp > XB_SPIN_CAP) { atomicAdd(&(bar)[XB_TMO], 1u); break; } } } } while (0)

struct XcdBarrier {
    unsigned* bar; unsigned x;
    volatile LAS unsigned* st;
};

__device__ __forceinline__ XcdBarrier xcd_barrier_post(unsigned* bar, volatile LAS unsigned* st) {
    XcdBarrier b; b.bar = bar; b.x = xb_xcc_id(); b.st = st;
    if (threadIdx.x == 0) (void)xb_add(&bar[XB_XCNT(b.x)], 1u);
    return b;
}
__device__ __forceinline__ void xcd_barrier_complete(unsigned* bar, unsigned x, unsigned& nloc, unsigned& nx) {
    const unsigned G = gridDim.x * gridDim.y * gridDim.z;
    unsigned sum, cnt, mine, sp = 0u;
    for (;;) {
        sum = 0u; cnt = 0u; mine = 0u;
#pragma unroll
        for (unsigned j = 0; j < 16; ++j) { const unsigned c = xb_ld(&bar[XB_XCNT(j)]); sum += c; cnt += (c > 0u) ? 1u : 0u; mine = (j == x) ? c : mine; }
        if (sum == G) break;
        __builtin_amdgcn_s_sleep(1);
        if ((++sp & 255u) == 0u) { if (xb_ld(&bar[XB_TMO])) break; if (sp > XB_SPIN_CAP) { atomicAdd(&bar[XB_TMO], 1u); break; } }
    }
    nloc = mine > 0u ? mine : 1u; nx = cnt > 0u ? cnt : 1u;
}

__device__ __forceinline__ void xcd_barrier(const XcdBarrier& b) {
    asm volatile("s_waitcnt vmcnt(0)" ::: "memory");
    __syncthreads();
    if (threadIdx.x == 0) {
        unsigned* bar = b.bar;
        __builtin_amdgcn_s_waitcnt(0);
        unsigned nloc = b.st[0], nx = b.st[1];
        if (nloc == 0u) { xcd_barrier_complete(bar, b.x, nloc, nx); b.st[0] = nloc; b.st[1] = nx; }
        const unsigned old = xb_add(&bar[XB_XSUB(b.x)], 1u);
        const unsigned gen = old / nloc;
        if (old + 1u == (gen + 1u) * nloc) {
            __builtin_amdgcn_fence(__ATOMIC_RELEASE, "agent");
            asm volatile("s_waitcnt vmcnt(0)" ::: "memory");
            const unsigned og = xb_add(&bar[XB_TOP], 1u);
            const unsigned tg = og / nx;
            if (og + 1u == (tg + 1u) * nx) xb_add(&bar[XB_TOPGEN], 1u);
            else XB_SPIN(xb_ld(&bar[XB_TOPGEN]) == tg, bar);
            __builtin_amdgcn_fence(__ATOMIC_ACQUIRE, "agent");
            xb_add(&bar[XB_XGEN(b.x)], 1u);
            asm volatile("s_waitcnt vmcnt(0)" ::: "memory");
        } else {
            XB_SPIN(xb_ld(&bar[XB_XGEN(b.x)]) == gen, bar);
            __builtin_amdgcn_fence(__ATOMIC_ACQUIRE, "agent");
            asm volatile("s_waitcnt vmcnt(0)" ::: "memory");
        }
    }
    __syncthreads();
}

#if defined(__HIP_DEVICE_COMPILE__)
__device__ __forceinline__ Params ldp() { auto* k = (const __attribute__((address_space(4))) Params*)__builtin_amdgcn_kernarg_segment_ptr(); asm volatile("" : "+s"(k)); return *k; }
#else
__device__ __forceinline__ Params ldp() { return Params{}; }
#endif
__global__ void __launch_bounds__(NTHREADS, 2) hymba_fwd(Params Parg) {
    extern __shared__ __attribute__((aligned(16))) unsigned char lds_raw[];
    if (Parg.ws == nullptr) { cg::this_grid().sync(); }
    LAS unsigned char* lds = (LAS unsigned char*)lds_raw;
    const int G = gridDim.x;
    { volatile LAS unsigned* z = (volatile LAS unsigned*)(lds + LDS_BYTES - 256); if (threadIdx.x < 64) z[threadIdx.x] = 0u; }
    __syncthreads();
    const XcdBarrier bar = xcd_barrier_post((unsigned*)(Parg.ws + WS_CTL) + CW_BAR, (volatile LAS unsigned*)(lds + LDS_BYTES - 256) + 8);
    const int wave0 = __builtin_amdgcn_readfirstlane(threadIdx.x >> 6);
#define PHASE_IDS() int wave = wave0; asm volatile("" : "+s"(wave)); unsigned ones_ = ~0u; asm volatile("" : "+s"(ones_)); int lane_ = (int)__builtin_amdgcn_mbcnt_hi(ones_, __builtin_amdgcn_mbcnt_lo(ones_, 0u)); asm volatile("" : "+v"(lane_)); const int lane = lane_ & 63; const int tid = wave * 64 + lane; (void)lane; (void)wave
#define PHASE_PTRS() const Params P = ldp(); unsigned* ctl = (unsigned*)(P.ws + WS_CTL); (void)ctl; \
    bf16* WinT = (bf16*)(P.ws + WS_WIN); bf16* WoutT = (bf16*)(P.ws + WS_WOUT); bf16* W1T = (bf16*)(P.ws + WS_W1); bf16* W2T = (bf16*)(P.ws + WS_W2); (void)WinT; (void)WoutT; (void)W1T; (void)W2T; \
    bf16* XN = (bf16*)(P.ws + WS_XN); bf16* ATT = (bf16*)(P.ws + WS_ATT); bf16* X1B = (bf16*)(P.ws + WS_X1B); bf16* Y2B = (bf16*)(P.ws + WS_Y2B); bf16* F = (bf16*)(P.ws + WS_F); float* PART = (float*)(P.ws + WS_PART); \
    float* STAT = (float*)(P.ws + WS_STAT); float* C1 = (float*)(P.ws + WS_C1); float* C2 = (float*)(P.ws + WS_C2); (void)XN; (void)ATT; (void)X1B; (void)Y2B; (void)F; (void)PART; (void)STAT; (void)C1; (void)C2

#ifndef PROBE_DUP
#define PROBE_DUP -1
#endif
#define REP(k) for (int rep_ = 0; rep_ < ((PROBE_DUP) == (k) ? 2 : 1); ++rep_)
    if (PROBE_DUP == 7) { for (int i = 0; i < 8; ++i) xcd_barrier(bar); }
    { PHASE_IDS(); PHASE_PTRS(); p0a_prologue(P, lds, wave, lane); }
    xcd_barrier(bar);
    { PHASE_IDS(); PHASE_PTRS();
      constexpr int NTAILU = ((MT - MAIN_ROWS) / 256) * (INC / 256);
      if ((int)blockIdx.x < NTAILU) {
          pg8::Gemm g{XN, WinT, MT, INC, DM, DM}; pg8::TailOrder S; S.init(MAIN_ROWS / 256, (MT - MAIN_ROWS) / 256, INC / 256, 1, NTAILU, (int)blockIdx.x);
          EpiInProj E{(bf16*)(P.ws + WS_R), (bf16*)(P.ws + WS_R + QSZ), (bf16*)(P.ws + WS_R + 2 * QSZ), (bf16*)(P.ws + WS_R + 3 * QSZ), P.out};
          pg8::gemm_phase<EpiInProj, pg8::TailOrder, true, true>(lds, g, S, E, tid);
          __syncthreads(); }
      p0b_queue(P, lds, ctl + 3072, wave, lane); }
    xcd_barrier(bar);
    REP(1) { PHASE_IDS(); PHASE_PTRS(); pg8::Gemm g{XN, WinT, MAIN_ROWS, INC, DM, DM}; pg8::StaticOrder S; S.init(MAIN_ROWS, INC, G, (int)blockIdx.x);
      EpiInProj E{(bf16*)(P.ws + WS_R), (bf16*)(P.ws + WS_R + QSZ), (bf16*)(P.ws + WS_R + 2 * QSZ), (bf16*)(P.ws + WS_R + 3 * QSZ), P.out};
      pg8::gemm_phase<EpiInProj, pg8::StaticOrder, true, true>(lds, g, S, E, tid); }
    xcd_barrier(bar);
    {
        PHASE_IDS(); PHASE_PTRS();
        LAS unsigned char* wl = lds + wave * WAVE_LDS;
        const int myx = (int)(xb_xcc_id() & 7u);
        for (int ra = 0; ra < ((PROBE_DUP == 2 || PROBE_DUP == 8) ? 2 : 1); ++ra)
        for (int qi = 0; qi < NH; ++qi) { const int hq = (myx + qi) & 7;
            unsigned* qc = ctl + 256 + 64 * hq + 1024 * ra;
            int item = 0;
            if (lane == 0) item = (int)atomicAdd(qc, 1u);
            item = __builtin_amdgcn_readfirstlane(item);
            while (item < ATT_PER_HEAD) {
                int nraw = 0;
                if (lane == 0) nraw = (int)atomicAdd(qc, 1u);
                attn_item(hq * ATT_PER_HEAD + item, P, wl, lane);
                item = __builtin_amdgcn_readfirstlane(nraw);
            } }
        __syncthreads();
        for (int rc = 0; rc < ((PROBE_DUP == 2 || PROBE_DUP == 9) ? 2 : 1); ++rc) { conv_phase(P, lds, ctl + 64 + 128 * rc, tid, wave, lane); __syncthreads(); }
    }
    xcd_barrier(bar);
    REP(3) {
    { PHASE_IDS(); PHASE_PTRS(); pg8::Gemm g{ATT, WoutT, MAIN_ROWS, DM, DM, DM}; pg8::StaticOrder S; S.init(MAIN_ROWS, DM, G, (int)blockIdx.x);
      EpiX1 E{XN, X1B, STAT};
      pg8::gemm_phase<EpiX1, pg8::StaticOrder, true, true>(lds, g, S, E, tid); }
    { PHASE_IDS(); PHASE_PTRS(); pg8::Gemm g{ATT, WoutT, MT, DM, DM / TAIL_S, DM}; pg8::TailOrder S; S.init(MAIN_ROWS / 256, (MT - MAIN_ROWS) / 256, DM / 256, TAIL_S, G, (int)blockIdx.x);
      EpiPart E{PART};
      pg8::gemm_phase<EpiPart, pg8::TailOrder, true, true>(lds, g, S, E, tid); }
    }
    xcd_barrier(bar);
    REP(4) { PHASE_IDS(); PHASE_PTRS(); const int gw = blockIdx.x * NWAVES + wave, NGW = G * NWAVES;
      for (int r = MAIN_ROWS + gw; r < MT; r += NGW) { f32x4 v[4]; load_row_bf16(XN + (size_t)r * DM, lane, v);
#pragma unroll
          for (int j = 0; j < 4; ++j) v[j] = v[j] * ALPHA;
          add_partials(PART + (size_t)(r - MAIN_ROWS) * DM, lane, v); store_row_bf16(X1B + (size_t)r * DM, lane, v);
          float s = 0.f, q = 0.f;
#pragma unroll
          for (int j = 0; j < 4; ++j) { const float a = bflo(pk2(v[j].x, 0.f)), b = bflo(pk2(v[j].y, 0.f)), c = bflo(pk2(v[j].z, 0.f)), d = bflo(pk2(v[j].w, 0.f)); s += (a + b) + (c + d); q += (a * a + b * b) + (c * c + d * d); }
          s = wave_sum(s); q = wave_sum(q);
          if (lane == 0) { STAT[2 * (size_t)r] = s; STAT[2 * (size_t)r + 1] = q; } } }
    xcd_barrier(bar);
    REP(5) { PHASE_IDS(); PHASE_PTRS(); pg8::Gemm g{X1B, W1T, MT, DFF, DM, DM}; pg8::StaticOrder S; S.init(MT, DFF, G, (int)blockIdx.x);
      EpiFF1 E{F, STAT, C1, C2};
      pg8::gemm_phase<EpiFF1, pg8::StaticOrder, true, true>(lds, g, S, E, tid); }
    xcd_barrier(bar);
    REP(6) {
    { PHASE_IDS(); PHASE_PTRS(); pg8::Gemm g{F, W2T, MAIN_ROWS, DM, DFF, DFF}; pg8::StaticOrder S; S.init(MAIN_ROWS, DM, G, (int)blockIdx.x);
      EpiY2 E{X1B, Y2B, STAT, P.g1, P.b1};
      pg8::gemm_phase<EpiY2, pg8::StaticOrder, true, true>(lds, g, S, E, tid); }
    { PHASE_IDS(); PHASE_PTRS(); pg8::Gemm g{F, W2T, MT, DM, DFF / TAIL_S, DFF}; pg8::TailOrder S; S.init(MAIN_ROWS / 256, (MT - MAIN_ROWS) / 256, DM / 256, TAIL_S, G, (int)blockIdx.x);
      EpiPart E{PART};
      pg8::gemm_phase<EpiPart, pg8::TailOrder, true, true>(lds, g, S, E, tid); }
    }
    xcd_barrier(bar);
    { PHASE_IDS(); PHASE_PTRS(); const int gw = blockIdx.x * NWAVES + wave, NGW = G * NWAVES; constexpr int NY = NB * SEQ + MS;
      auto y_load = [&](int m, f32x4 (&v)[4]) {
          const int r = m < NB * SEQ ? (m >> 11) * LP + NMETA + (m & (SEQ - 1)) : MP + (m - NB * SEQ);
          if (r < MAIN_ROWS) load_row_bf16(Y2B + (size_t)r * DM, lane, v);
          else { load_row_bf16(X1B + (size_t)r * DM, lane, v); float mean, rstd; stat_mr(STAT, r, mean, rstd); affine_row(mean, rstd, P.g1, P.b1, lane, v);
#pragma unroll
              for (int j = 0; j < 4; ++j) v[j] = v[j] * ALPHA;
              add_partials(PART + (size_t)(r - MAIN_ROWS) * DM, lane, v); } };
      auto y_store = [&](int m, f32x4 (&v)[4]) { float* row = P.out + (size_t)m * DM;
#pragma unroll
          for (int j = 0; j < 4; ++j) __builtin_nontemporal_store(v[j], (f32x4*)row + lane + 64 * j); };
      for (int m = gw; m < NY; m += 2 * NGW) {
          const int m1 = m + NGW; const bool has1 = m1 < NY;
          f32x4 v0[4], v1[4];
          y_load(m, v0); if (has1) y_load(m1, v1);
          ln_apply(P.g2, P.b2, lane, v0); y_store(m, v0);
          if (has1) { ln_apply(P.g2, P.b2, lane, v1); y_store(m1, v1); } } }
}

extern "C" void kernel_launch(void* const* d_in, const int* in_sizes, int n_in, void* d_out, int out_size, void* d_ws, size_t ws_size, hipStream_t stream) {
    static int grid = 0;
    if (grid == 0) {
        if (n_in != 20 || (size_t)out_size != OUT_TOTAL || ws_size < WS_END3) { fprintf(stderr, "kernel_launch: unexpected problem: n_in %d out %d ws %zu (need %zu)\n", n_in, out_size, ws_size, (size_t)WS_END3); grid = -1; return; }
        int dev = 0, cus = 0, per_cu = 0;
        if (hipGetDevice(&dev) != hipSuccess || hipDeviceGetAttribute(&cus, hipDeviceAttributeMultiprocessorCount, dev) != hipSuccess) { grid = -1; return; }
        if (hipFuncSetAttribute((const void*)hymba_fwd, hipFuncAttributeMaxDynamicSharedMemorySize, LDS_BYTES) != hipSuccess) { fprintf(stderr, "kernel_launch: hipFuncSetAttribute failed\n"); grid = -1; return; }
        if (hipOccupancyMaxActiveBlocksPerMultiprocessor(&per_cu, (const void*)hymba_fwd, NTHREADS, LDS_BYTES) != hipSuccess || per_cu < 1) { fprintf(stderr, "kernel_launch: occupancy query says %d\n", per_cu); (void)hipGetLastError(); per_cu = 1; }
        if (per_cu > 1) per_cu = 1;
        grid = cus * per_cu;
    }
    if (grid < 0) return;
    (void)hipMemsetAsync((char*)d_ws + WS_CTL, 0, CTL_BYTES, stream);
    Params p{};
    p.x_prompt = (const float*)d_in[0]; p.x_sample = (const float*)d_in[1]; p.cache_k = (const float*)d_in[2]; p.cache_v = (const float*)d_in[3]; p.state_conv = (const float*)d_in[4];
    p.meta = (const float*)d_in[5]; p.g_in = (const float*)d_in[6]; p.b_in = (const float*)d_in[7]; p.w_in = (const float*)d_in[8]; p.w_dw = (const float*)d_in[9]; p.b_dw = (const float*)d_in[10];
    p.g_conv = (const float*)d_in[11]; p.b_conv = (const float*)d_in[12]; p.w_out = (const float*)d_in[13]; p.g1 = (const float*)d_in[14]; p.b1 = (const float*)d_in[15];
    p.w_ff1 = (const float*)d_in[16]; p.w_ff2 = (const float*)d_in[17]; p.g2 = (const float*)d_in[18]; p.b2 = (const float*)d_in[19];
    p.out = (float*)d_out; p.ws = (unsigned char*)d_ws;
    void* args[] = {&p};
    hipError_t e = hipLaunchCooperativeKernel((const void*)hymba_fwd, dim3(grid), dim3(NTHREADS), args, LDS_BYTES, stream);
    if (e != hipSuccess) fprintf(stderr, "kernel_launch: cooperative launch failed: %s (grid %d)\n", hipGetErrorString(e), grid);
}
```

```cpp
#include <hip/hip_runtime.h>
#include <hip/hip_cooperative_groups.h>
#include <cstdio>
#include <cstdint>
namespace cg = cooperative_groups;
namespace pg8 {
#define PG8_LAS __attribute__((address_space(3)))
typedef unsigned short bf16_t;
typedef short bf16x8 __attribute__((ext_vector_type(8)));
typedef float f32x4 __attribute__((ext_vector_type(4)));
typedef unsigned u32x4 __attribute__((ext_vector_type(4)));
constexpr int BM = 256, BK = 64, HALF = 128, HTB = HALF * BK * 2  , STAGE_BYTES = 8 * HTB, NXCD = 8, WGM = 8;

__host__ __device__ __forceinline__ int lds_byte(int r, int c) { const int st = (r >> 4) * 2 + (c >> 5), rr = r & 15, cc = c & 31, ob = rr * 64 + cc * 2; return st * 1024 + (ob ^ (((ob >> 9) & 1) << 5)); }
__host__ __device__ __forceinline__ void stage_rc(int b, int& R, int& C) { const int st = b / 1024, sb = b % 1024, swz = sb ^ (((sb >> 9) & 1) << 5); R = (st >> 1) * 16 + swz / 64; C = (st & 1) * 32 + (swz % 64) / 2; }
__host__ __device__ __forceinline__ int perm32(int rho) { const int n = rho >> 4, i = rho & 15; return 8 * (i >> 2) + 4 * n + (i & 3); }

struct Unit { int pm, pn, pk; };
struct Gemm { const bf16_t* A; const bf16_t* Bt; int M, N, K, ld; };

struct StaticOrder {
    int nM, nN, nwg, G, c;
    __host__ __device__ void init(int M, int N, int G_, int c_) { nM = M / BM; nN = N / BM; nwg = nM * nN; G = G_; c = c_; }
    __host__ __device__ bool next(int i, Unit& u) const {
        const long L = (long)i * G + c; if (L >= nwg) return false;
        int wgid = (int)L; { const int q = nwg / NXCD, r = nwg % NXCD, xcd = wgid % NXCD, off = wgid / NXCD; wgid = (xcd < r ? xcd * (q + 1) : r * (q + 1) + (xcd - r) * q) + off; }
        const int nig = WGM * nN, gid = wgid / nig, fm = gid * WGM, gsz = (nM - fm) < WGM ? (nM - fm) : WGM;
        u.pm = fm + ((wgid % nig) % gsz); u.pn = (wgid % nig) / gsz; u.pk = 0; return true;
    }
    __device__ __forceinline__ void a_ready(const Unit&) const {}
    __device__ __forceinline__ void done(const Unit&) const {}
};

struct TailOrder {
    int pm0, nN, S, n, G, c;
    __host__ __device__ void init(int pm0_, int nM_, int nN_, int S_, int G_, int c_) { pm0 = pm0_; nN = nN_; S = S_; n = nM_ * nN_ * S_; G = G_; c = c_; }
    __host__ __device__ bool next(int i, Unit& u) const {
        const long L = (long)i * G + c; if (L >= n) return false;
        const int l = (int)L, rem = l / S; u.pk = l - rem * S; u.pn = rem % nN; u.pm = pm0 + rem / nN; return true;
    }
    __device__ __forceinline__ void a_ready(const Unit&) const {}
    __device__ __forceinline__ void done(const Unit&) const {}
};

__device__ __forceinline__ unsigned cvt_pk_bf16(float lo, float hi) { unsigned r; asm volatile("v_cvt_pk_bf16_f32 %0, %1, %2" : "=v"(r) : "v"(lo), "v"(hi)); return r; }
template <class Epi, class Sched, bool ALIGN_EPI = false, bool SP2 = false>
__device__ __forceinline__ void gemm_phase(PG8_LAS unsigned char* lds, const Gemm g, const Sched& S, const Epi& E, int tid_in) {
    int tid_ = tid_in; asm volatile("" : "+v"(tid_));
    const int tid = tid_, wid = __builtin_amdgcn_readfirstlane(tid >> 6), lane = tid & 63, wr = wid >> 2, wc = wid & 3, fr = lane & 15, fq = lane >> 4;
    const int K = g.ld, nt = g.K / BK;
    const size_t kchunk = (size_t)g.K * 2;
    unsigned voffA[2], voffB[2];
#pragma unroll
    for (int i = 0; i < 2; ++i) { int R, C; stage_rc(tid * 16 + i * 8192, R, C); const int Rb = Epi::PERM ? ((R & ~31) + perm32(R & 31)) : R;
        voffA[i] = (unsigned)(R * K + C) * 2u; voffB[i] = (unsigned)(Rb * K + C) * 2u; }
    const size_t kstep = (size_t)(BK * 2);
    const size_t hstep = (size_t)HALF * K * 2;
    const size_t tstep = 2 * hstep;
    const unsigned ldsw = (unsigned)wid * 1024u;
    const int aoff = lds_byte(wr * 64 + fr, fq * 8), boff = lds_byte(wc * 32 + fr, fq * 8);
#define PG8_SA(b, h) (((b) * 2 + (h)) * HTB)
#define PG8_SB(b, h) ((4 + (b) * 2 + (h)) * HTB)
#define PG8_STAGE(bufoff, gbase, voff) do { _Pragma("unroll") for (int _i = 0; _i < 2; ++_i) \
        __builtin_amdgcn_global_load_lds((const unsigned*)((const char*)(gbase) + (voff)[_i]), (PG8_LAS unsigned*)(lds + (bufoff) + ldsw + _i * 8192), 16, 0, 0); } while (0)
#define PG8_LDA(dst, b, h) do { _Pragma("unroll") for (int m = 0; m < 4; ++m) _Pragma("unroll") for (int k = 0; k < 2; ++k) dst[m][k] = *(const PG8_LAS bf16x8*)(lds + PG8_SA(b, h) + aoff + m * 2048 + k * 1024); } while (0)
#define PG8_LDB(dst, b, h) do { _Pragma("unroll") for (int n = 0; n < 2; ++n) _Pragma("unroll") for (int k = 0; k < 2; ++k) dst[n][k] = *(const PG8_LAS bf16x8*)(lds + PG8_SB(b, h) + boff + n * 2048 + k * 1024); } while (0)
#define PG8_MMA(ai, bj, At, Bt) do { __builtin_amdgcn_s_setprio(1); _Pragma("unroll") for (int m = 0; m < 4; ++m) _Pragma("unroll") for (int n = 0; n < 2; ++n) _Pragma("unroll") for (int k = 0; k < 2; ++k) \
        acc[ai][bj][m][n] = __builtin_amdgcn_mfma_f32_16x16x32_bf16(Bt[n][k], At[m][k], acc[ai][bj][m][n], 0, 0, 0); __builtin_amdgcn_s_setprio(0); } while (0)
#define PG8_WAIT_V(n) asm volatile("s_waitcnt vmcnt(" #n ")" ::: "memory")
#define PG8_WAIT_L(n) asm volatile("s_waitcnt lgkmcnt(" #n ")" ::: "memory")
#define PG8_BAR __builtin_amdgcn_s_barrier()
#define PG8_SCHED __builtin_amdgcn_sched_barrier(0)
    Unit cur, nxt; int ui = 0;
    if (!S.next(0, cur)) return;
    f32x4 acc[2][2][4][2];
#pragma unroll
    for (int a = 0; a < 2; ++a)
#pragma unroll
        for (int b = 0; b < 2; ++b)
#pragma unroll
            for (int m = 0; m < 4; ++m)
#pragma unroll
                for (int n = 0; n < 2; ++n) acc[a][b][m][n] = (f32x4){0.f, 0.f, 0.f, 0.f};
    bf16x8 At[4][2], B0[2][2], B1[2][2];
    const char* cA = (const char*)g.A + (size_t)cur.pm * tstep + (size_t)cur.pk * kchunk; const char* cB = (const char*)g.Bt + (size_t)cur.pn * tstep + (size_t)cur.pk * kchunk;
    S.a_ready(cur);
    if constexpr (SP2) {
        PG8_STAGE(PG8_SB(0, 0), cB, voffB); PG8_STAGE(PG8_SB(0, 1), cB + hstep, voffB); PG8_STAGE(PG8_SA(0, 0), cA, voffA); PG8_STAGE(PG8_SA(0, 1), cA + hstep, voffA);
        if (wr == 1) PG8_BAR;
        PG8_WAIT_V(2); PG8_BAR;
        PG8_STAGE(PG8_SB(1, 0), cB + kstep, voffB); PG8_STAGE(PG8_SA(1, 0), cA + kstep, voffA); PG8_STAGE(PG8_SB(1, 1), cB + hstep + kstep, voffB);
        PG8_WAIT_V(6); PG8_BAR;
    } else {
        PG8_STAGE(PG8_SB(0, 0), cB, voffB); PG8_STAGE(PG8_SA(0, 0), cA, voffA); PG8_STAGE(PG8_SB(0, 1), cB + hstep, voffB); PG8_STAGE(PG8_SA(0, 1), cA + hstep, voffA);
        if (wr == 1) PG8_BAR;
        PG8_WAIT_V(4); PG8_BAR;
        PG8_STAGE(PG8_SB(1, 0), cB + kstep, voffB); PG8_STAGE(PG8_SA(1, 0), cA + kstep, voffA); PG8_STAGE(PG8_SB(1, 1), cB + hstep + kstep, voffB);
        PG8_WAIT_V(6); PG8_BAR;
    }
    for (;;) {
        const bool has_next = S.next(ui + 1, nxt);
        const char* nA = has_next ? (const char*)g.A + (size_t)nxt.pm * tstep + (size_t)nxt.pk * kchunk : cA; const char* nB = has_next ? (const char*)g.Bt + (size_t)nxt.pn * tstep + (size_t)nxt.pk * kchunk : cB;
        for (int t = 0; t < nt; t += 2) {
            const bool last = (t == nt - 2);
            const char* a1 = cA + (size_t)(t + 1) * kstep;
            const char* a2 = last ? nA : cA + (size_t)(t + 2) * kstep; const char* b2 = last ? nB : cB + (size_t)(t + 2) * kstep;
            const char* a3 = a2 + kstep; const char* b3 = b2 + kstep;
            if (last && has_next) S.a_ready(nxt);
            if constexpr (SP2) {
            PG8_LDB(B0, 0, 0); PG8_LDB(B1, 0, 1); PG8_SCHED; PG8_LDA(At, 0, 0); PG8_STAGE(PG8_SA(1, 1), a1 + hstep, voffA);
            PG8_WAIT_V(8); PG8_WAIT_L(0); PG8_BAR; PG8_MMA(0, 0, At, B0); PG8_MMA(0, 1, At, B1); PG8_BAR; PG8_SCHED;
            PG8_LDA(At, 0, 1); PG8_STAGE(PG8_SB(0, 0), b2, voffB); PG8_STAGE(PG8_SB(0, 1), b2 + hstep, voffB); PG8_STAGE(PG8_SA(0, 0), a2, voffA);
            PG8_WAIT_V(8); PG8_WAIT_L(0); PG8_BAR; PG8_MMA(1, 0, At, B0); PG8_MMA(1, 1, At, B1); PG8_BAR; PG8_SCHED;
            PG8_LDB(B0, 1, 0); PG8_LDB(B1, 1, 1); PG8_SCHED; PG8_LDA(At, 1, 0); PG8_STAGE(PG8_SA(0, 1), a2 + hstep, voffA);
            PG8_WAIT_V(8); PG8_WAIT_L(0); PG8_BAR; PG8_MMA(0, 0, At, B0); PG8_MMA(0, 1, At, B1); PG8_BAR; PG8_SCHED;
            PG8_LDA(At, 1, 1); PG8_STAGE(PG8_SB(1, 0), b3, voffB); PG8_STAGE(PG8_SB(1, 1), b3 + hstep, voffB); PG8_STAGE(PG8_SA(1, 0), a3, voffA);
            PG8_WAIT_V(8); PG8_WAIT_L(0); PG8_BAR; PG8_MMA(1, 0, At, B0); PG8_MMA(1, 1, At, B1); PG8_BAR; PG8_SCHED;
            } else {
            PG8_LDB(B0, 0, 0); PG8_SCHED; PG8_LDA(At, 0, 0); PG8_STAGE(PG8_SA(1, 1), a1 + hstep, voffA);
            PG8_WAIT_L(8); PG8_BAR; PG8_WAIT_L(0); PG8_MMA(0, 0, At, B0); PG8_BAR; PG8_SCHED;
            PG8_LDB(B1, 0, 1); PG8_STAGE(PG8_SB(0, 0), b2, voffB);
            PG8_BAR; PG8_WAIT_L(0); PG8_MMA(0, 1, At, B1); PG8_BAR;
            PG8_LDA(At, 0, 1); PG8_STAGE(PG8_SA(0, 0), a2, voffA);
            PG8_BAR; PG8_WAIT_L(0); PG8_MMA(1, 0, At, B0); PG8_BAR; PG8_SCHED;
            PG8_STAGE(PG8_SB(0, 1), b2 + hstep, voffB);
            PG8_WAIT_V(6); PG8_BAR; PG8_MMA(1, 1, At, B1); PG8_BAR;
            PG8_LDB(B0, 1, 0); PG8_SCHED; PG8_LDA(At, 1, 0); PG8_STAGE(PG8_SA(0, 1), a2 + hstep, voffA);
            PG8_WAIT_L(8); PG8_BAR; PG8_WAIT_L(0); PG8_MMA(0, 0, At, B0); PG8_BAR; PG8_SCHED;
            PG8_LDB(B1, 1, 1); PG8_STAGE(PG8_SB(1, 0), b3, voffB);
            PG8_BAR; PG8_WAIT_L(0); PG8_MMA(0, 1, At, B1); PG8_BAR;
            PG8_LDA(At, 1, 1); PG8_STAGE(PG8_SA(1, 0), a3, voffA);
            PG8_BAR; PG8_WAIT_L(0); PG8_MMA(1, 0, At, B0); PG8_BAR; PG8_SCHED;
            PG8_STAGE(PG8_SB(1, 1), b3 + hstep, voffB);
            PG8_WAIT_V(6); PG8_BAR; PG8_MMA(1, 1, At, B1); PG8_BAR;
            }
        }
        if constexpr (ALIGN_EPI) { if (wr == 0) PG8_BAR; }
        if constexpr (!Epi::AFTER_DRAIN) { E(acc, cur, wr, wc, fr, fq); S.done(cur); }
        if (!has_next) break;
#pragma unroll
        for (int a = 0; a < 2; ++a)
#pragma unroll
            for (int b = 0; b < 2; ++b)
#pragma unroll
                for (int m = 0; m < 4; ++m)
#pragma unroll
                    for (int n = 0; n < 2; ++n) acc[a][b][m][n] = (f32x4){0.f, 0.f, 0.f, 0.f};
        cur = nxt; cA = nA; cB = nB; ++ui;
        if constexpr (ALIGN_EPI) { if (wr == 1) PG8_BAR; }
    }
    PG8_WAIT_V(0);
    if constexpr (!ALIGN_EPI) { if (wr == 0) PG8_BAR; }
    PG8_BAR;
    if constexpr (Epi::AFTER_DRAIN) { E.fused(acc, cur, wr, wc, fr, fq, lds, wid, lane); S.done(cur); }
#undef PG8_SA
#undef PG8_SB
#undef PG8_STAGE
#undef PG8_LDA
#undef PG8_LDB
#undef PG8_MMA
#undef PG8_WAIT_V
#undef PG8_WAIT_L
#undef PG8_BAR
#undef PG8_SCHED
}
}

#define LAS __attribute__((address_space(3)))
typedef unsigned short bf16;
typedef unsigned v4u __attribute__((ext_vector_type(4)));
typedef unsigned v2u __attribute__((ext_vector_type(2)));
typedef float f32x4 __attribute__((ext_vector_type(4)));
typedef float f32x16 __attribute__((ext_vector_type(16)));
typedef short bf16x8 __attribute__((ext_vector_type(8)));
typedef short s16x4 __attribute__((ext_vector_type(4)));
typedef float f32x2_t __attribute__((ext_vector_type(2)));
typedef __bf16 bf16x2_t __attribute__((ext_vector_type(2)));

constexpr int DM = 1024, NB = 16, SEQ = 2048, NMETA = 16, LP = NMETA + SEQ, NDB = 32, DSQ = 32, PAST = 2048, NH = 8, HD = 64;
constexpr int AW = 512, CC = 512, CK = 31, DFF = 4096, INC = 2560;
constexpr int MP = NB * LP;
constexpr int MS = NDB * DSQ;
constexpr int MT = MP + MS;
static_assert(MT % 256 == 0 && MP % 256 == 0, "row tiles");
constexpr float ALPHA = 1.189207115002721f;
constexpr float LN_EPS = 1e-5f;
constexpr float QSCALE = 0.125f * 1.4426950408889634f;

constexpr size_t OFF_YP = 0, OFF_YS = (size_t)NB * SEQ * DM, OFF_KP = OFF_YS + (size_t)MS * DM, OFF_VP = OFF_KP + (size_t)MP * AW,
                 OFF_CP = OFF_VP + (size_t)MP * AW, OFF_KS = OFF_CP + (size_t)NB * 30 * CC, OFF_VS = OFF_KS + (size_t)MS * AW, OFF_CS = OFF_VS + (size_t)MS * AW,
                 OUT_TOTAL = OFF_CS + (size_t)NDB * 30 * CC;

constexpr size_t MiB = 1u << 20;
constexpr size_t WS_CTL = 0, CTL_BYTES = 344064, WS_C1 = 32768, WS_C2 = 49152, WS_STAT = 65536;
constexpr size_t CTL_OLD_BYTES = 65536;
constexpr int CW_BAR = 4096;
constexpr size_t WS_WIN = 1 * MiB, WS_WOUT = 6 * MiB, WS_W1 = 8 * MiB, WS_W2 = 16 * MiB;
constexpr size_t WS_ATT = 24 * MiB;
constexpr size_t WS_R = 91 * MiB;
constexpr size_t QSZ = (size_t)MT * 512 * 2;
constexpr size_t WS_XN = 224 * MiB;
constexpr size_t WS_F = 91 * MiB;
constexpr size_t WS_END = WS_F + (size_t)MT * DFF * 2;
static_assert(WS_ATT + (size_t)MT * DM * 2 <= WS_R && WS_R + 4 * QSZ <= WS_XN && WS_R + (size_t)MT * DM * 4 <= WS_XN, "ws map");

constexpr int MAIN_ROWS = 32768;
constexpr int TAIL_ROWS = MT - MAIN_ROWS, TAIL_S = 8;
constexpr size_t WS_PART = 360 * MiB;
constexpr size_t WS_END2 = WS_PART + (size_t)TAIL_S * TAIL_ROWS * DM * 4;
static_assert(WS_END <= WS_PART, "ws map 2");
constexpr size_t WS_X1B = 402 * MiB;
constexpr size_t WS_Y2B = WS_ATT;
constexpr size_t WS_END3 = WS_X1B + (size_t)MT * DM * 2;
static_assert(WS_END2 <= WS_X1B && WS_STAT + (size_t)MT * 8 <= CTL_BYTES && CTL_BYTES <= WS_WIN, "ws map 3");
constexpr int LDS_BYTES = 149504;
constexpr int NTHREADS = 512, NWAVES = 8;

struct Params {
    const float *x_prompt, *x_sample, *cache_k, *cache_v, *state_conv, *meta, *g_in, *b_in, *w_in, *w_dw, *b_dw, *g_conv, *b_conv, *w_out, *g1, *b1, *w_ff1, *w_ff2, *g2, *b2;
    float* out; unsigned char* ws;
};

__device__ __forceinline__ unsigned pk2(float lo, float hi) { f32x2_t v = {lo, hi}; bf16x2_t b = __builtin_convertvector(v, bf16x2_t); return __builtin_bit_cast(unsigned, b); }
__device__ __forceinline__ float bflo(unsigned w) { return __uint_as_float(w << 16); }
__device__ __forceinline__ float bfhi(unsigned w) { return __uint_as_float(w & 0xffff0000u); }
__device__ __forceinline__ float wave_sum(float v) {
#pragma unroll
    for (int o = 1; o < 64; o <<= 1) v += __shfl_xor(v, o);
    return v;
}

__device__ __forceinline__ void transpose_item(const float* W, int K, int N, bf16* WT, int dst_row0, LAS float* scr, int k0, int n0, int lane) {
    { float t[32]; const float* wp = W + (size_t)(k0 + (lane >> 5)) * N + n0 + (lane & 31);
#pragma unroll
      for (int i = 0; i < 32; ++i) t[i] = wp[(size_t)(2 * i) * N];
#pragma unroll
      for (int i = 0; i < 32; ++i) scr[(2 * i + (lane >> 5)) * 33 + (lane & 31)] = t[i]; }
    asm volatile("s_waitcnt lgkmcnt(0)" ::: "memory");
    const int c = lane & 7;
#pragma unroll
    for (int j = 0; j < 4; ++j) { const int n = (lane >> 3) + 8 * j; const LAS float* s = scr + (8 * c) * 33 + n;
        v4u o; o.x = pk2(s[0 * 33], s[1 * 33]); o.y = pk2(s[2 * 33], s[3 * 33]); o.z = pk2(s[4 * 33], s[5 * 33]); o.w = pk2(s[6 * 33], s[7 * 33]);
        *(v4u*)(WT + (size_t)(dst_row0 + n) * K + k0 + 8 * c) = o; }
    asm volatile("s_waitcnt lgkmcnt(0)" ::: "memory");
}
__device__ __forceinline__ void transpose_item_w1(const float* W, int K, int N, bf16* WT, const float* g1, const float* b1, float* c1, float* c2, LAS float* scr, int k0, int n0, int lane) {
    { float t[32]; const float* wp = W + (size_t)(k0 + (lane >> 5)) * N + n0 + (lane & 31);
#pragma unroll
      for (int i = 0; i < 32; ++i) t[i] = wp[(size_t)(2 * i) * N];
#pragma unroll
      for (int i = 0; i < 32; ++i) scr[(2 * i + (lane >> 5)) * 33 + (lane & 31)] = t[i]; }
    asm volatile("s_waitcnt lgkmcnt(0)" ::: "memory");
    const int c = lane & 7;
    const f32x4 ga = *(const f32x4*)(g1 + k0 + 8 * c), gb = *(const f32x4*)(g1 + k0 + 8 * c + 4), ba = *(const f32x4*)(b1 + k0 + 8 * c), bb = *(const f32x4*)(b1 + k0 + 8 * c + 4);
#pragma unroll
    for (int j = 0; j < 4; ++j) { const int n = (lane >> 3) + 8 * j; const LAS float* s = scr + (8 * c) * 33 + n;
        const float w0 = s[0 * 33], w1 = s[1 * 33], w2 = s[2 * 33], w3 = s[3 * 33], w4 = s[4 * 33], w5 = s[5 * 33], w6 = s[6 * 33], w7 = s[7 * 33];
        v4u o; o.x = pk2(w0 * ga[0], w1 * ga[1]); o.y = pk2(w2 * ga[2], w3 * ga[3]); o.z = pk2(w4 * gb[0], w5 * gb[1]); o.w = pk2(w6 * gb[2], w7 * gb[3]);
        *(v4u*)(WT + (size_t)(n0 + n) * K + k0 + 8 * c) = o;
        float r1 = ((bflo(o.x) + bfhi(o.x)) + (bflo(o.y) + bfhi(o.y))) + ((bflo(o.z) + bfhi(o.z)) + (bflo(o.w) + bfhi(o.w)));
        float r2 = ((w0 * ba[0] + w1 * ba[1]) + (w2 * ba[2] + w3 * ba[3])) + ((w4 * bb[0] + w5 * bb[1]) + (w6 * bb[2] + w7 * bb[3]));
        r1 += __shfl_xor(r1, 1); r2 += __shfl_xor(r2, 1); r1 += __shfl_xor(r1, 2); r2 += __shfl_xor(r2, 2); r1 += __shfl_xor(r1, 4); r2 += __shfl_xor(r2, 4);
        if (c == 0) { unsafeAtomicAdd(c1 + n0 + n, r1); unsafeAtomicAdd(c2 + n0 + n, r2); } }
    asm volatile("s_waitcnt lgkmcnt(0)" ::: "memory");
}
__device__ __forceinline__ int win_dst_row(int c) {
    if (c < 1536) return c;
    if (c < 2048) { const int ch = c - 1536; return 1536 + 256 * (ch >> 7) + (ch & 127); }
    const int ch = c - 2048; return 1536 + 256 * (ch >> 7) + 128 + (ch & 127);
}
__device__ __forceinline__ void load_row_f32(const float* xrow, int lane, f32x4 (&v)[4]) {
#pragma unroll
    for (int j = 0; j < 4; ++j) v[j] = ((const f32x4*)xrow)[lane + 64 * j];
}
__device__ __forceinline__ void load_row_bf16(const bf16* xrow, int lane, f32x4 (&v)[4]) {
#pragma unroll
    for (int j = 0; j < 4; ++j) { const v2u rw = ((const v2u*)xrow)[lane + 64 * j]; v[j][0] = bflo(rw.x); v[j][1] = bfhi(rw.x); v[j][2] = bflo(rw.y); v[j][3] = bfhi(rw.y); }
}
__device__ __forceinline__ void add_partials(const float* part, int lane, f32x4 (&v)[4]) {
#pragma unroll
    for (int c = 0; c < TAIL_S; ++c)
#pragma unroll
        for (int j = 0; j < 4; ++j) v[j] += ((const f32x4*)(part + (size_t)c * TAIL_ROWS * DM))[lane + 64 * j];
}
__device__ __forceinline__ void affine_row(float mean, float rstd, const float* g, const float* b, int lane, f32x4 (&v)[4]) {
#pragma unroll
    for (int j = 0; j < 4; ++j) { const f32x4 gg = ((const f32x4*)g)[lane + 64 * j], bb = ((const f32x4*)b)[lane + 64 * j]; v[j] = (v[j] - mean) * rstd * gg + bb; }
}
__device__ __forceinline__ void ln_apply(const float* g, const float* b, int lane, f32x4 (&v)[4]) {
    float s = 0.f;
#pragma unroll
    for (int j = 0; j < 4; ++j) s += (v[j].x + v[j].y) + (v[j].z + v[j].w);
    const float mean = wave_sum(s) * (1.f / DM); float s2 = 0.f;
#pragma unroll
    for (int j = 0; j < 4; ++j) { const f32x4 d = v[j] - mean; s2 += (d.x * d.x + d.y * d.y) + (d.z * d.z + d.w * d.w); }
    const float rstd = 1.f / sqrtf(wave_sum(s2) * (1.f / DM) + LN_EPS);
    affine_row(mean, rstd, g, b, lane, v);
}
__device__ __forceinline__ void stat_mr(const float* stat, int row, float& mean, float& rstd) {
    const f32x2_t st = *(const f32x2_t*)(stat + 2 * (size_t)row); mean = st.x * (1.f / DM); rstd = __builtin_amdgcn_rsqf(fmaxf(st.y * (1.f / DM) - mean * mean, 0.f) + LN_EPS);
}
__device__ __forceinline__ void store_row_bf16(bf16* orow, int lane, const f32x4 (&v)[4]) {
    v2u* o8 = (v2u*)orow + lane;
#pragma unroll
    for (int j = 0; j < 4; ++j) { v2u w; w.x = pk2(v[j].x, v[j].y); w.y = pk2(v[j].z, v[j].w); o8[64 * j] = w; }
}

__device__ __forceinline__ const float* ln_in_src(const Params& P, int m) {
    if (m < MP) { const int b = m / LP, t = m - b * LP; return (t < NMETA) ? P.meta + (size_t)t * DM : P.x_prompt + ((size_t)b * SEQ + (t - NMETA)) * DM; }
    return P.x_sample + (size_t)(m - MP) * DM;
}
__device__ __forceinline__ void ln_in_pair(const Params& P, bf16* XN, int m, int m1, bool has1, int lane) {
    f32x4 v0[4], v1[4];
    load_row_f32(ln_in_src(P, m), lane, v0);
    if (has1) load_row_f32(ln_in_src(P, m1), lane, v1);
    ln_apply(P.g_in, P.b_in, lane, v0); store_row_bf16(XN + (size_t)m * DM, lane, v0);
    if (has1) { ln_apply(P.g_in, P.b_in, lane, v1); store_row_bf16(XN + (size_t)m1 * DM, lane, v1); }
}
__device__ __forceinline__ void p0a_prologue(const Params& P, LAS unsigned char* lds, int wave, int lane) {
    LAS float* scr = (LAS float*)(lds + wave * 16384);
    const int gw = blockIdx.x * NWAVES + wave, NGW = gridDim.x * NWAVES;
    bf16* WinT = (bf16*)(P.ws + WS_WIN); bf16* XN = (bf16*)(P.ws + WS_XN);
    constexpr int I_IN = (DM / 64) * (INC / 32);
    for (int it = gw; it < I_IN; it += NGW) { const int nblk = INC / 32, kb = it / nblk, nb = it % nblk; transpose_item(P.w_in, DM, INC, WinT, win_dst_row(32 * nb), scr, 64 * kb, 32 * nb, lane); }
    for (int m = MAIN_ROWS + gw; m < MT; m += NGW) ln_in_pair(P, XN, m, m, false, lane);
}
constexpr int P0B_LN = MAIN_ROWS / 16, P0B_OUT = (DM / 64) * (DM / 32), P0B_1 = (DM / 64) * (DFF / 32), P0B_2 = (DFF / 64) * (DM / 32), P0B_ITEMS = P0B_LN + P0B_OUT + P0B_1 + P0B_2;
__device__ __forceinline__ void p0b_queue(const Params& P, LAS unsigned char* lds, unsigned* ctr, int wave, int lane) {
    LAS float* scr = (LAS float*)(lds + wave * 16384);
    bf16* WoutT = (bf16*)(P.ws + WS_WOUT); bf16* W1T = (bf16*)(P.ws + WS_W1); bf16* W2T = (bf16*)(P.ws + WS_W2); bf16* XN = (bf16*)(P.ws + WS_XN);
    LAS int* bc = (LAS int*)(lds + LDS_BYTES - 512);
    for (;;) {
        if (threadIdx.x == 0) bc[0] = (int)atomicAdd(ctr, 1u);
        __syncthreads();
        const int grp = bc[0];
        __syncthreads();
        if (grp * 8 >= P0B_ITEMS) break;
        int r = grp * 8 + wave;
        if (r < P0B_LN) {
#pragma unroll 1
            for (int k = 0; k < 8; ++k) ln_in_pair(P, XN, 16 * r + 2 * k, 16 * r + 2 * k + 1, true, lane);
            continue; } r -= P0B_LN;
        if (r < P0B_OUT) { const int nblk = DM / 32, kb = r / nblk, nb = r % nblk; transpose_item(P.w_out, DM, DM, WoutT, 32 * nb, scr, 64 * kb, 32 * nb, lane); continue; } r -= P0B_OUT;
        if (r < P0B_1) { const int nblk = DFF / 32, kb = r / nblk, nb = r % nblk; transpose_item_w1(P.w_ff1, DM, DFF, W1T, P.g1, P.b1, (float*)(P.ws + WS_C1), (float*)(P.ws + WS_C2), scr, 64 * kb, 32 * nb, lane); continue; } r -= P0B_1;
        { const int nblk = DM / 32, kb = r / nblk, nb = r % nblk; transpose_item(P.w_ff2, DFF, DM, W2T, 32 * nb, scr, 64 * kb, 32 * nb, lane); }
    }
}

using pg8::Unit;
struct EpiInProj {
    static constexpr bool PERM = true, AFTER_DRAIN = false;
    bf16 *Q, *K, *V, *U; float* out;
    __device__ __forceinline__ void operator()(const f32x4 (&acc)[2][2][4][2], const Unit& u, int wr, int wc, int fr, int fq) const {
        const int pn = u.pn, rbase = u.pm * 256 + wr * 64 + fr;
        const bool prompt = (u.pm * 256) < MP;
        if (pn < 6) {
            const int seg = pn >> 1;
            bf16* B = Q + (size_t)seg * ((size_t)MT * 512);
            const float sc = seg == 0 ? QSCALE : 1.f;
            const int colt = (pn & 1) * 256 + wc * 32 + 8 * fq;
            float* fo = out + (prompt ? OFF_KP + (size_t)(seg - 1) * (OFF_VP - OFF_KP) : OFF_KS + (size_t)(seg - 1) * (OFF_VS - OFF_KS));
#pragma unroll
            for (int ai = 0; ai < 2; ++ai)
#pragma unroll
                for (int m = 0; m < 4; ++m) { const int row = rbase + ai * 128 + m * 16; const int frow = prompt ? row : row - MP;
#pragma unroll
                    for (int bj = 0; bj < 2; ++bj) { const int col = colt + bj * 128; f32x4 v0 = acc[ai][bj][m][0], v1 = acc[ai][bj][m][1]; if (seg == 0) { v0 = v0 * sc; v1 = v1 * sc; }
                        v4u w; w.x = pk2(v0[0], v0[1]); w.y = pk2(v0[2], v0[3]); w.z = pk2(v1[0], v1[1]); w.w = pk2(v1[2], v1[3]);
                        *(v4u*)(B + (size_t)row * 512 + col) = w;
                        if (seg > 0) { float* p = fo + (size_t)frow * 512 + col; __builtin_nontemporal_store(v0, (f32x4*)p); __builtin_nontemporal_store(v1, (f32x4*)(p + 4)); } } }
        } else {
            const int ch0 = (pn - 6) * 128 + wc * 32 + 8 * fq;
#pragma unroll
            for (int ai = 0; ai < 2; ++ai)
#pragma unroll
                for (int m = 0; m < 4; ++m) { const int row = rbase + ai * 128 + m * 16;
                    f32x4 uu[2];
#pragma unroll
                    for (int n = 0; n < 2; ++n) { const f32x4 a = acc[ai][0][m][n], g = acc[ai][1][m][n];
#pragma unroll
                        for (int e = 0; e < 4; ++e) uu[n][e] = a[e] * __builtin_amdgcn_rcpf(1.f + __expf(-g[e])); }
                    v4u w; w.x = pk2(uu[0][0], uu[0][1]); w.y = pk2(uu[0][2], uu[0][3]); w.z = pk2(uu[1][0], uu[1][1]); w.w = pk2(uu[1][2], uu[1][3]);
                    *(v4u*)(U + (size_t)row * 512 + ch0) = w;
                    if (prompt) { const int b = row / LP, t = row - b * LP;
                        if (t >= LP - 30) { float* p = out + OFF_CP + ((size_t)(b * 30 + t - (LP - 30))) * CC + ch0; *(f32x4*)p = uu[0]; *(f32x4*)(p + 4) = uu[1]; } }
                    else { const int rs = row - MP, db = rs >> 5, i = rs & 31;
                        if (i >= 2) { float* p = out + OFF_CS + ((size_t)(db * 30 + i - 2)) * CC + ch0; *(f32x4*)p = uu[0]; *(f32x4*)(p + 4) = uu[1]; } } }
        }
    }
};
struct EpiX1 {
    static constexpr bool PERM = true, AFTER_DRAIN = false;
    const bf16* res; bf16* dst; float* stat;
    __device__ __forceinline__ void operator()(const f32x4 (&acc)[2][2][4][2], const Unit& u, int wr, int wc, int fr, int fq) const {
        const int rbase = u.pm * 256 + wr * 64 + fr, cbase = u.pn * 256 + wc * 32 + 8 * fq;
#pragma unroll
        for (int ai = 0; ai < 2; ++ai)
#pragma unroll
            for (int m = 0; m < 4; ++m) { const int row = rbase + ai * 128 + m * 16; const size_t ro = (size_t)row * DM;
                float s = 0.f, q = 0.f;
#pragma unroll
                for (int bj = 0; bj < 2; ++bj) { const int c = cbase + bj * 128; const v4u rw = *(const v4u*)(res + ro + c);
                    const f32x4 v0 = acc[ai][bj][m][0], v1 = acc[ai][bj][m][1];
                    v4u w; w.x = pk2(ALPHA * bflo(rw.x) + v0[0], ALPHA * bfhi(rw.x) + v0[1]); w.y = pk2(ALPHA * bflo(rw.y) + v0[2], ALPHA * bfhi(rw.y) + v0[3]);
                    w.z = pk2(ALPHA * bflo(rw.z) + v1[0], ALPHA * bfhi(rw.z) + v1[1]); w.w = pk2(ALPHA * bflo(rw.w) + v1[2], ALPHA * bfhi(rw.w) + v1[3]);
                    *(v4u*)(dst + ro + c) = w;
#pragma unroll
                    for (int e = 0; e < 4; ++e) { const float a = bflo(w[e]), b = bfhi(w[e]); s += a + b; q += a * a + b * b; } }
                s += __shfl_xor(s, 16); q += __shfl_xor(q, 16); s += __shfl_xor(s, 32); q += __shfl_xor(q, 32);
                if (fq == 0) { unsafeAtomicAdd(stat + 2 * (size_t)row, s); unsafeAtomicAdd(stat + 2 * (size_t)row + 1, q); } }
    }
};
struct EpiFF1 {
    static constexpr bool PERM = true, AFTER_DRAIN = false;
    bf16* F; const float* stat; const float* c1; const float* c2;
    __device__ __forceinline__ void operator()(const f32x4 (&acc)[2][2][4][2], const Unit& u, int wr, int wc, int fr, int fq) const {
        const int rbase = u.pm * 256 + wr * 64 + fr, cbase = u.pn * 256 + wc * 32 + 8 * fq;
        f32x4 c1v[2][2], c2v[2][2];
#pragma unroll
        for (int bj = 0; bj < 2; ++bj)
#pragma unroll
            for (int n = 0; n < 2; ++n) { c1v[bj][n] = *(const f32x4*)(c1 + cbase + bj * 128 + 4 * n); c2v[bj][n] = *(const f32x4*)(c2 + cbase + bj * 128 + 4 * n); }
#pragma unroll
        for (int ai = 0; ai < 2; ++ai)
#pragma unroll
            for (int m = 0; m < 4; ++m) { const int row = rbase + ai * 128 + m * 16; bf16* rowp = F + (size_t)row * DFF + cbase;
                float mean, rstd; stat_mr(stat, row, mean, rstd);
#pragma unroll
                for (int bj = 0; bj < 2; ++bj) { f32x4 v0 = (acc[ai][bj][m][0] - mean * c1v[bj][0]) * rstd + c2v[bj][0], v1 = (acc[ai][bj][m][1] - mean * c1v[bj][1]) * rstd + c2v[bj][1];
#pragma unroll
                    for (int e = 0; e < 4; ++e) { const float a = fmaxf(v0[e], 0.f), b = fmaxf(v1[e], 0.f); v0[e] = a * a; v1[e] = b * b; }
                    v4u w; w.x = pk2(v0[0], v0[1]); w.y = pk2(v0[2], v0[3]); w.z = pk2(v1[0], v1[1]); w.w = pk2(v1[2], v1[3]);
                    *(v4u*)(rowp + bj * 128) = w; } }
    }
};
struct EpiY2 {
    static constexpr bool PERM = true, AFTER_DRAIN = false;
    const bf16* x1b; bf16* dst; const float* stat; const float* g1; const float* b1;
    __device__ __forceinline__ void operator()(const f32x4 (&acc)[2][2][4][2], const Unit& u, int wr, int wc, int fr, int fq) const {
        const int rbase = u.pm * 256 + wr * 64 + fr, cbase = u.pn * 256 + wc * 32 + 8 * fq;
        f32x4 gv[2][2], bv[2][2];
#pragma unroll
        for (int bj = 0; bj < 2; ++bj)
#pragma unroll
            for (int n = 0; n < 2; ++n) { gv[bj][n] = *(const f32x4*)(g1 + cbase + bj * 128 + 4 * n) * ALPHA; bv[bj][n] = *(const f32x4*)(b1 + cbase + bj * 128 + 4 * n) * ALPHA; }
#pragma unroll
        for (int ai = 0; ai < 2; ++ai)
#pragma unroll
            for (int m = 0; m < 4; ++m) { const int row = rbase + ai * 128 + m * 16; const size_t ro = (size_t)row * DM;
                const int t = row % LP;
                if (t >= NMETA) {
                    float mean, rstd; stat_mr(stat, row, mean, rstd);
#pragma unroll
                    for (int bj = 0; bj < 2; ++bj) { const int c = cbase + bj * 128; const v4u rw = *(const v4u*)(x1b + ro + c);
                        f32x4 x0, x1; x0[0] = bflo(rw.x); x0[1] = bfhi(rw.x); x0[2] = bflo(rw.y); x0[3] = bfhi(rw.y); x1[0] = bflo(rw.z); x1[1] = bfhi(rw.z); x1[2] = bflo(rw.w); x1[3] = bfhi(rw.w);
                        const f32x4 o0 = (x0 - mean) * rstd * gv[bj][0] + bv[bj][0] + acc[ai][bj][m][0], o1 = (x1 - mean) * rstd * gv[bj][1] + bv[bj][1] + acc[ai][bj][m][1];
                        v4u w; w.x = pk2(o0[0], o0[1]); w.y = pk2(o0[2], o0[3]); w.z = pk2(o1[0], o1[1]); w.w = pk2(o1[2], o1[3]);
                        *(v4u*)(dst + ro + c) = w; } } }
    }
};
struct EpiPart {
    static constexpr bool PERM = false, AFTER_DRAIN = false;
    float* part;
    __device__ __forceinline__ void operator()(const f32x4 (&acc)[2][2][4][2], const Unit& u, int wr, int wc, int fr, int fq) const {
        const int rbase = u.pm * 256 - MAIN_ROWS + wr * 64 + fr, cbase = u.pn * 256 + wc * 32 + 4 * fq;
        float* pb = part + (size_t)u.pk * TAIL_ROWS * DM;
#pragma unroll
        for (int ai = 0; ai < 2; ++ai)
#pragma unroll
            for (int m = 0; m < 4; ++m) { const size_t ro = (size_t)(rbase + ai * 128 + m * 16) * DM;
#pragma unroll
                for (int bj = 0; bj < 2; ++bj)
#pragma unroll
                    for (int n = 0; n < 2; ++n) *(f32x4*)(pb + ro + cbase + bj * 128 + n * 16) = acc[ai][bj][m][n]; }
    }
};
constexpr int KS = 144;
constexpr int WAVE_LDS = 2 * 64 * KS;
constexpr int ATT_PER_HEAD = NDB + NB * 65;
constexpr int N_ATT_ITEMS = NH * ATT_PER_HEAD;
constexpr float EXIT_THR = 160.f;
#define MFMA32(a, b, c) __builtin_amdgcn_mfma_f32_32x32x16_bf16((a), (b), (c), 0, 0, 0)
typedef short v4i16_t __attribute__((ext_vector_type(4)));
__device__ __forceinline__ s16x4 vtr(const LAS unsigned char* p) { return __builtin_bit_cast(s16x4, __builtin_amdgcn_ds_read_tr16_b64_v4i16((LAS v4i16_t*)p)); }
__device__ __forceinline__ int clampi(int v, int lo, int hi) { return v < lo ? lo : (v > hi ? hi : v); }

__device__ __forceinline__ void attn_tile(const LAS unsigned char* Kl, const LAS unsigned char* Vl, const bf16x8 (&qf)[4], float& carry, f32x16 (&o)[2], bool needmask, int k0, int p0, int lane) {
    const int r32 = lane & 31, hi = lane >> 5;
    f32x16 z0, z1;
#pragma unroll
    for (int r = 0; r < 16; ++r) { z0[r] = 0.f; z1[r] = 0.f; }
    const LAS unsigned char* kp = Kl + r32 * KS + hi * 16;
#pragma unroll
    for (int d0 = 0; d0 < 4; ++d0) {
        const bf16x8 a0 = *(const LAS bf16x8*)(kp + d0 * 32);
        const bf16x8 a1 = *(const LAS bf16x8*)(kp + 32 * KS + d0 * 32);
        z0 = MFMA32(a0, qf[d0], z0); z1 = MFMA32(a1, qf[d0], z1);
    }
    if (needmask) {
        const int q = p0 + r32;
#pragma unroll
        for (int r = 0; r < 16; ++r) { const int s = k0 + 8 * (r >> 2) + 4 * hi + (r & 3);
            if (!(s < q && s >= 0)) z0[r] = -INFINITY;
            if (!(s + 32 < q && s + 32 >= 0)) z1[r] = -INFINITY; }
    }
    f32x16 s0, s1;
#pragma unroll
    for (int r = 0; r < 16; ++r) {
        s0[r] = fmaxf(z0[r], 0.f) + __builtin_amdgcn_logf(1.f + __builtin_amdgcn_exp2f(-fabsf(z0[r])));
        s1[r] = fmaxf(z1[r], 0.f) + __builtin_amdgcn_logf(1.f + __builtin_amdgcn_exp2f(-fabsf(z1[r])));
    }
#pragma unroll
    for (int g = 0; g < 4; ++g) {
        s0[4 * g + 2] += s0[4 * g + 3]; s0[4 * g + 1] += s0[4 * g + 2]; s0[4 * g] += s0[4 * g + 1];
        s1[4 * g + 2] += s1[4 * g + 3]; s1[4 * g + 1] += s1[4 * g + 2]; s1[4 * g] += s1[4 * g + 1];
    }
    float lo[8], hh[8];
#pragma unroll
    for (int g = 0; g < 8; ++g) { const float gs = g < 4 ? s0[4 * g] : s1[4 * (g - 4)];
        auto rr = __builtin_amdgcn_permlane32_swap(__float_as_uint(gs), __float_as_uint(gs), false, false);
        lo[g] = __uint_as_float(rr[0]); hh[g] = __uint_as_float(rr[1]); }
    float base[8]; float run = carry;
#pragma unroll
    for (int g = 7; g >= 0; --g) { base[g] = run + (hi == 0 ? hh[g] : 0.f); run += lo[g] + hh[g]; }
    carry = run;
#pragma unroll
    for (int r = 0; r < 16; ++r) {
        z0[r] = __builtin_amdgcn_exp2f(z0[r] - (s0[r] + base[r >> 2]));
        z1[r] = __builtin_amdgcn_exp2f(z1[r] - (s1[r] + base[4 + (r >> 2)]));
    }
    const LAS unsigned char* vp = Vl + (4 * hi + ((lane & 15) >> 2)) * KS + ((lane >> 4) & 1) * 32 + (lane & 3) * 8;
#pragma unroll
    for (int blk = 0; blk < 2; ++blk)
#pragma unroll
        for (int s = 0; s < 2; ++s) {
            v4u pw;
            if (blk == 0) { pw.x = pk2(z0[8 * s], z0[8 * s + 1]); pw.y = pk2(z0[8 * s + 2], z0[8 * s + 3]); pw.z = pk2(z0[8 * s + 4], z0[8 * s + 5]); pw.w = pk2(z0[8 * s + 6], z0[8 * s + 7]); }
            else          { pw.x = pk2(z1[8 * s], z1[8 * s + 1]); pw.y = pk2(z1[8 * s + 2], z1[8 * s + 3]); pw.z = pk2(z1[8 * s + 4], z1[8 * s + 5]); pw.w = pk2(z1[8 * s + 6], z1[8 * s + 7]); }
            const bf16x8 pa = __builtin_bit_cast(bf16x8, pw);
#pragma unroll
            for (int db = 0; db < 2; ++db) {
                const LAS unsigned char* vq = vp + (blk * 32 + 16 * s) * KS + db * 64;
                const s16x4 l4 = vtr(vq), h4 = vtr(vq + 8 * KS);
                const bf16x8 vb = __builtin_shufflevector(l4, h4, 0, 1, 2, 3, 4, 5, 6, 7);
                o[db] = MFMA32(pa, vb, o[db]);
            }
        }
}

__device__ __forceinline__ void attn_item(int item, const Params& P, LAS unsigned char* wl, int lane) {
    const int r32 = lane & 31, hi = lane >> 5;
    const bf16* Qb = (const bf16*)(P.ws + WS_R); const bf16* Kb = (const bf16*)(P.ws + WS_R + QSZ); const bf16* Vb = (const bf16*)(P.ws + WS_R + 2 * QSZ);
    bf16* ATT = (bf16*)(P.ws + WS_ATT);
    LAS unsigned char* Kl = wl; LAS unsigned char* Vl = wl + 64 * KS;
    const int hidx = item / ATT_PER_HEAD, local = item - hidx * ATT_PER_HEAD;
    const bool sample = local < NDB;
    int p0, seqrow0, lmax, ntile, db = 0;
    if (sample) { db = local; p0 = 0; seqrow0 = MP + db * DSQ; lmax = DSQ - 1; ntile = 33; }
    else { const int j = local - NDB, b = j / 65, i = 63 - (j - b * 65); p0 = NMETA + 32 * i; seqrow0 = b * LP; lmax = LP - 1; ntile = (p0 + 31) / 64 + 1; }
    bf16x8 qf[4];
    { const size_t qrow = (size_t)(seqrow0 + clampi(p0 + r32, 0, lmax));
#pragma unroll
      for (int d0 = 0; d0 < 4; ++d0) qf[d0] = *(const bf16x8*)(Qb + qrow * 512 + hidx * 64 + d0 * 16 + hi * 8); }
    f32x16 o[2];
#pragma unroll
    for (int r = 0; r < 16; ++r) { o[0][r] = 0.f; o[1][r] = 0.f; }
    float carry = 0.f;
    const int key_l = lane >> 3, ch = lane & 7;
    const int kfirst = sample ? 0 : p0 - 32;
    v4u kreg[8], vreg[8];
#define LOAD_BF16_TILE(k0_) do { _Pragma("unroll") for (int it = 0; it < 8; ++it) { const size_t row = (size_t)(seqrow0 + clampi((k0_) + 8 * it + key_l, 0, lmax)); \
        kreg[it] = *(const v4u*)(Kb + row * 512 + hidx * 64 + ch * 8); vreg[it] = *(const v4u*)(Vb + row * 512 + hidx * 64 + ch * 8); } } while (0)
#define STORE_TILE() do { _Pragma("unroll") for (int it = 0; it < 8; ++it) { *(LAS v4u*)(Kl + (8 * it + key_l) * KS + ch * 16) = kreg[it]; *(LAS v4u*)(Vl + (8 * it + key_l) * KS + ch * 16) = vreg[it]; } } while (0)
    LOAD_BF16_TILE(kfirst);
    STORE_TILE();
    if (!sample) {
        for (int t = 0; t < ntile; ++t) {
            const int k0 = kfirst - 64 * t;
            if (t + 1 < ntile) LOAD_BF16_TILE(k0 - 64);
            asm volatile("s_waitcnt lgkmcnt(0)" ::: "memory");
            attn_tile(Kl, Vl, qf, carry, o, (k0 < 0) || (k0 + 63 >= p0), k0, p0, lane);
            asm volatile("s_waitcnt lgkmcnt(0)" ::: "memory");
            if (__all(carry > EXIT_THR)) break;
            if (t + 1 < ntile) STORE_TILE();
        }
    } else {
        asm volatile("s_waitcnt lgkmcnt(0)" ::: "memory");
        attn_tile(Kl, Vl, qf, carry, o, true, 0, 0, lane);
        asm volatile("s_waitcnt lgkmcnt(0)" ::: "memory");
        for (int kt = 31; kt >= 0; --kt) {
            if (__all(carry > EXIT_THR)) break;
            const float* ck = P.cache_k + ((size_t)(db * PAST + 64 * kt + key_l) * 512 + hidx * 64 + ch * 8);
            const float* cv = P.cache_v + ((size_t)(db * PAST + 64 * kt + key_l) * 512 + hidx * 64 + ch * 8);
#pragma unroll
            for (int it = 0; it < 8; ++it) { const f32x4 a = *(const f32x4*)(ck + (size_t)it * 8 * 512), b = *(const f32x4*)(ck + (size_t)it * 8 * 512 + 4);
                kreg[it].x = pk2(a[0], a[1]); kreg[it].y = pk2(a[2], a[3]); kreg[it].z = pk2(b[0], b[1]); kreg[it].w = pk2(b[2], b[3]); }
#pragma unroll
            for (int it = 0; it < 8; ++it) { const f32x4 a = *(const f32x4*)(cv + (size_t)it * 8 * 512), b = *(const f32x4*)(cv + (size_t)it * 8 * 512 + 4);
                vreg[it].x = pk2(a[0], a[1]); vreg[it].y = pk2(a[2], a[3]); vreg[it].z = pk2(b[0], b[1]); vreg[it].w = pk2(b[2], b[3]); }
            STORE_TILE();
            asm volatile("s_waitcnt lgkmcnt(0)" ::: "memory");
            attn_tile(Kl, Vl, qf, carry, o, false, 0, 0, lane);
            asm volatile("s_waitcnt lgkmcnt(0)" ::: "memory");
        }
    }
#undef LOAD_BF16_TILE
#undef STORE_TILE
#pragma unroll
    for (int r = 0; r < 16; ++r) { const int q = (r & 3) + 8 * (r >> 2) + 4 * hi, p = p0 + q;
        if (p >= 0) { bf16* dst = ATT + (size_t)(seqrow0 + p) * DM + hidx * 64 + r32;
            dst[0] = (bf16)(pk2(o[0][r], 0.f) & 0xffffu); dst[32] = (bf16)(pk2(o[1][r], 0.f) & 0xffffu); } }
}

constexpr int N_CONV_ITEMS = NB * 65 + NDB;
constexpr int CV_XS = 0, CV_C = 62 * 1024;
struct ConvItem { int seqrow0, t0, tlen, db; bool sample; };
__device__ __forceinline__ ConvItem conv_decode(int item) {
    ConvItem c; c.sample = item >= NB * 65; c.db = 0;
    if (c.sample) { c.db = item - NB * 65; c.seqrow0 = MP + c.db * DSQ; c.t0 = 0; c.tlen = DSQ; }
    else { const int b = item / 65, tt = item - b * 65; c.seqrow0 = b * LP; c.t0 = 32 * tt; c.tlen = LP; }
    return c;
}
__device__ __forceinline__ void conv_load(const ConvItem& ci, const Params& P, int tid, v4u (&st)[8]) {
    const bf16* Ub = (const bf16*)(P.ws + WS_R + 3 * QSZ);
#pragma unroll
    for (int i = 0; i < 8; ++i) { const int c = tid + NTHREADS * i, x = c >> 6, c8 = c & 63, t = ci.t0 - 30 + x;
        v4u w = {0u, 0u, 0u, 0u};
        if (x < 62) {
            if (t >= 0) { if (t < ci.tlen) w = *(const v4u*)(Ub + (size_t)(ci.seqrow0 + t) * 512 + c8 * 8); }
            else if (ci.sample) { const float* sp = P.state_conv + ((size_t)(ci.db * 30 + x)) * CC + c8 * 8; const f32x4 a = *(const f32x4*)sp, b = *(const f32x4*)(sp + 4);
                w.x = pk2(a[0], a[1]); w.y = pk2(a[2], a[3]); w.z = pk2(b[0], b[1]); w.w = pk2(b[2], b[3]); } }
        st[i] = w; }
}
__device__ __forceinline__ void conv_store(LAS unsigned char* lds, int tid, const v4u (&st)[8]) {
#pragma unroll
    for (int i = 0; i < 8; ++i) { const int c = tid + NTHREADS * i, x = c >> 6, c8 = c & 63; if (x < 62) *(LAS v4u*)(lds + CV_XS + x * 1024 + c8 * 16) = st[i]; }
}
__device__ __forceinline__ void conv_phase(const Params& P, LAS unsigned char* lds, unsigned* ctr, int tid, int wave, int lane) {
    bf16* ATT = (bf16*)(P.ws + WS_ATT);
    LAS int* bc = (LAS int*)(lds + LDS_BYTES - 512);
    float wj[CK];
#pragma unroll
    for (int j = 0; j < CK; ++j) wj[j] = P.w_dw[j * CC + tid];
    const float bias = P.b_dw[tid];
    const f32x4 gc0 = *(const f32x4*)(P.g_conv + lane * 8), gc1 = *(const f32x4*)(P.g_conv + lane * 8 + 4), bc0 = *(const f32x4*)(P.b_conv + lane * 8), bc1 = *(const f32x4*)(P.b_conv + lane * 8 + 4);
    if (tid == 0) { bc[0] = (int)atomicAdd(ctr, 1u); bc[1] = (int)atomicAdd(ctr, 1u); }
    __syncthreads();
    int cur = bc[0], nxt = bc[1];
    v4u st[8];
    if (cur < N_CONV_ITEMS) { const ConvItem ci = conv_decode(cur); conv_load(ci, P, tid, st); conv_store(lds, tid, st); }
    __syncthreads();
    const LAS bf16* xs = (const LAS bf16*)(lds + CV_XS) + tid;
    LAS float* cbuf = (LAS float*)(lds + CV_C) + tid;
    while (cur < N_CONV_ITEMS) {
        const ConvItem ci = conv_decode(cur);
        if (tid == 0) bc[2] = (int)atomicAdd(ctr, 1u);
        if (nxt < N_CONV_ITEMS) { const ConvItem cn = conv_decode(nxt); conv_load(cn, P, tid, st); }
#pragma unroll 1
        for (int blk = 0; blk < 4; ++blk) {
            float acc[8];
#pragma unroll
            for (int oo = 0; oo < 8; ++oo) acc[oo] = bias;
#pragma unroll
            for (int x = 0; x < 38; ++x) { const float v = __uint_as_float((unsigned)xs[(8 * blk + x) * 512] << 16);
#pragma unroll
                for (int oo = 0; oo < 8; ++oo) { const int j = x - oo; if (j >= 0 && j < CK) acc[oo] += wj[j] * v; } }
#pragma unroll
            for (int oo = 0; oo < 8; ++oo) cbuf[(8 * blk + oo) * 512] = acc[oo];
        }
        __syncthreads();
        const int nn = bc[2];
        if (nxt < N_CONV_ITEMS) conv_store(lds, tid, st);
        {
            f32x4 a[4], b[4]; float s[4], q[4];
#pragma unroll
            for (int k = 0; k < 4; ++k) { const LAS float* cr = (const LAS float*)(lds + CV_C) + (wave + 8 * k) * 512 + lane * 8; a[k] = *(const LAS f32x4*)cr; b[k] = *(const LAS f32x4*)(cr + 4);
                s[k] = ((a[k][0] + a[k][1]) + (a[k][2] + a[k][3])) + ((b[k][0] + b[k][1]) + (b[k][2] + b[k][3])); }
#pragma unroll
            for (int o = 1; o < 64; o <<= 1) {
#pragma unroll
                for (int k = 0; k < 4; ++k) s[k] += __shfl_xor(s[k], o); }
#pragma unroll
            for (int k = 0; k < 4; ++k) { const float mean = s[k] * (1.f / CC); a[k] = a[k] - mean; b[k] = b[k] - mean;
                q[k] = ((a[k][0] * a[k][0] + a[k][1] * a[k][1]) + (a[k][2] * a[k][2] + a[k][3] * a[k][3])) + ((b[k][0] * b[k][0] + b[k][1] * b[k][1]) + (b[k][2] * b[k][2] + b[k][3] * b[k][3])); }
#pragma unroll
            for (int o = 1; o < 64; o <<= 1) {
#pragma unroll
                for (int k = 0; k < 4; ++k) q[k] += __shfl_xor(q[k], o); }
#pragma unroll
            for (int k = 0; k < 4; ++k) { const int t = ci.t0 + wave + 8 * k;
                if (t < ci.tlen) {
                    const float rstd = 1.f / sqrtf(q[k] * (1.f / CC) + LN_EPS);
                    f32x4 x = a[k] * rstd * gc0 + bc0, y = b[k] * rstd * gc1 + bc1;
#pragma unroll
                    for (int e = 0; e < 4; ++e) { x[e] = x[e] * __builtin_amdgcn_rcpf(1.f + __expf(-x[e])); y[e] = y[e] * __builtin_amdgcn_rcpf(1.f + __expf(-y[e])); }
                    v4u w; w.x = pk2(x[0], x[1]); w.y = pk2(x[2], x[3]); w.z = pk2(y[0], y[1]); w.w = pk2(y[2], y[3]);
                    *(v4u*)(ATT + (size_t)(ci.seqrow0 + t) * DM + AW + lane * 8) = w; } }
        }
        __syncthreads();
        cur = nxt; nxt = nn;
    }
}

#define XB_TMO      128
#define XB_XCNT(j)  (256  + 64 * (j))
#define XB_XSUB(j)  (1280 + 64 * (j))
#define XB_XGEN(j)  (2304 + 64 * (j))
#define XB_TOP      3328
#define XB_TOPGEN   3392
#define XCD_BAR_WORDS 3456
#define XB_SPIN_CAP (1u << 18)

__device__ __forceinline__ unsigned xb_ld(unsigned* p)              { return __hip_atomic_load(p, __ATOMIC_RELAXED, __HIP_MEMORY_SCOPE_AGENT); }
__device__ __forceinline__ unsigned xb_add(unsigned* p, unsigned v) { return __hip_atomic_fetch_add(p, v, __ATOMIC_RELAXED, __HIP_MEMORY_SCOPE_AGENT); }
__device__ __forceinline__ unsigned xb_xcc_id() { return (unsigned)__builtin_amdgcn_s_getreg((3 << 11) | 20) & 0xFu; }
#define XB_SPIN(cond, bar) do { unsigned _sp = 0; while (cond) { __builtin_amdgcn_s_sleep(1); \
    if ((++_sp & 255u) == 0u) { if (xb_ld(&(bar)[XB_TMO])) break; if (_sp > XB_SPIN_CAP) { atomicAdd(&(bar)[XB_TMO], 1u); break; } } } } while (0)

struct XcdBarrier {
    unsigned* bar; unsigned x;
    volatile LAS unsigned* st;
};

__device__ __forceinline__ XcdBarrier xcd_barrier_post(unsigned* bar, volatile LAS unsigned* st) {
    XcdBarrier b; b.bar = bar; b.x = xb_xcc_id(); b.st = st;
    if (threadIdx.x == 0) (void)xb_add(&bar[XB_XCNT(b.x)], 1u);
    return b;
}
__device__ __forceinline__ void xcd_barrier_complete(unsigned* bar, unsigned x, unsigned& nloc, unsigned& nx) {
    const unsigned G = gridDim.x * gridDim.y * gridDim.z;
    unsigned sum, cnt, mine, sp = 0u;
    for (;;) {
        sum = 0u; cnt = 0u; mine = 0u;
#pragma unroll
        for (unsigned j = 0; j < 16; ++j) { const unsigned c = xb_ld(&bar[XB_XCNT(j)]); sum += c; cnt += (c > 0u) ? 1u : 0u; mine = (j == x) ? c : mine; }
        if (sum == G) break;
        __builtin_amdgcn_s_sleep(1);
        if ((++sp & 255u) == 0u) { if (xb_ld(&bar[XB_TMO])) break; if (sp > XB_SPIN_CAP) { atomicAdd(&bar[XB_TMO], 1u); break; } }
    }
    nloc = mine > 0u ? mine : 1u; nx = cnt > 0u ? cnt : 1u;
}

__device__ __forceinline__ void xcd_barrier(const XcdBarrier& b) {
    asm volatile("s_waitcnt vmcnt(0)" ::: "memory");
    __syncthreads();
    if (threadIdx.x == 0) {
        unsigned* bar = b.bar;
        __builtin_amdgcn_s_waitcnt(0);
        unsigned nloc = b.st[0], nx = b.st[1];
        if (nloc == 0u) { xcd_barrier_complete(bar, b.x, nloc, nx); b.st[0] = nloc; b.st[1] = nx; }
        const unsigned old = xb_add(&bar[XB_XSUB(b.x)], 1u);
        const unsigned gen = old / nloc;
        if (old + 1u == (gen + 1u) * nloc) {
            __builtin_amdgcn_fence(__ATOMIC_RELEASE, "agent");
            asm volatile("s_waitcnt vmcnt(0)" ::: "memory");
            const unsigned og = xb_add(&bar[XB_TOP], 1u);
            const unsigned tg = og / nx;
            if (og + 1u == (tg + 1u) * nx) xb_add(&bar[XB_TOPGEN], 1u);
            else XB_SPIN(xb_ld(&bar[XB_TOPGEN]) == tg, bar);
            __builtin_amdgcn_fence(__ATOMIC_ACQUIRE, "agent");
            xb_add(&bar[XB_XGEN(b.x)], 1u);
            asm volatile("s_waitcnt vmcnt(0)" ::: "memory");
        } else {
            XB_SPIN(xb_ld(&bar[XB_XGEN(b.x)]) == gen, bar);
            __builtin_amdgcn_fence(__ATOMIC_ACQUIRE, "agent");
            asm volatile("s_waitcnt vmcnt(0)" ::: "memory");
        }
    }
    __syncthreads();
}

#if defined(__HIP_DEVICE_COMPILE__)
__device__ __forceinline__ Params ldp() { auto* k = (const __attribute__((address_space(4))) Params*)__builtin_amdgcn_kernarg_segment_ptr(); asm volatile("" : "+s"(k)); return *k; }
#else
__device__ __forceinline__ Params ldp() { return Params{}; }
#endif
__global__ void __launch_bounds__(NTHREADS, 2) hymba_fwd(Params Parg) {
    extern __shared__ __attribute__((aligned(16))) unsigned char lds_raw[];
    if (Parg.ws == nullptr) { cg::this_grid().sync(); }
    LAS unsigned char* lds = (LAS unsigned char*)lds_raw;
    const int G = gridDim.x;
    { volatile LAS unsigned* z = (volatile LAS unsigned*)(lds + LDS_BYTES - 256); if (threadIdx.x < 64) z[threadIdx.x] = 0u; }
    __syncthreads();
    const XcdBarrier bar = xcd_barrier_post((unsigned*)(Parg.ws + WS_CTL) + CW_BAR, (volatile LAS unsigned*)(lds + LDS_BYTES - 256) + 8);
    if (threadIdx.x == 0) { const unsigned r_ = xb_add((unsigned*)(Parg.ws + WS_CTL) + 3584 + (bar.x & 7u), 1u); ((volatile LAS unsigned*)(lds + LDS_BYTES - 256))[16] = r_ * 8u + (bar.x & 7u); }
    const int wave0 = __builtin_amdgcn_readfirstlane(threadIdx.x >> 6);
#define PHASE_IDS() int wave = wave0; asm volatile("" : "+s"(wave)); unsigned ones_ = ~0u; asm volatile("" : "+s"(ones_)); int lane_ = (int)__builtin_amdgcn_mbcnt_hi(ones_, __builtin_amdgcn_mbcnt_lo(ones_, 0u)); asm volatile("" : "+v"(lane_)); const int lane = lane_ & 63; const int tid = wave * 64 + lane; (void)lane; (void)wave
#define PHASE_PTRS() const Params P = ldp(); unsigned* ctl = (unsigned*)(P.ws + WS_CTL); (void)ctl; \
    bf16* WinT = (bf16*)(P.ws + WS_WIN); bf16* WoutT = (bf16*)(P.ws + WS_WOUT); bf16* W1T = (bf16*)(P.ws + WS_W1); bf16* W2T = (bf16*)(P.ws + WS_W2); (void)WinT; (void)WoutT; (void)W1T; (void)W2T; \
    bf16* XN = (bf16*)(P.ws + WS_XN); bf16* ATT = (bf16*)(P.ws + WS_ATT); bf16* X1B = (bf16*)(P.ws + WS_X1B); bf16* Y2B = (bf16*)(P.ws + WS_Y2B); bf16* F = (bf16*)(P.ws + WS_F); float* PART = (float*)(P.ws + WS_PART); \
    float* STAT = (float*)(P.ws + WS_STAT); float* C1 = (float*)(P.ws + WS_C1); float* C2 = (float*)(P.ws + WS_C2); (void)XN; (void)ATT; (void)X1B; (void)Y2B; (void)F; (void)PART; (void)STAT; (void)C1; (void)C2

#ifndef PROBE_DUP
#define PROBE_DUP -1
#endif
#define REP(k) for (int rep_ = 0; rep_ < ((PROBE_DUP) == (k) ? 2 : 1); ++rep_)
    if (PROBE_DUP == 7) { for (int i = 0; i < 8; ++i) xcd_barrier(bar); }
    { PHASE_IDS(); PHASE_PTRS(); p0a_prologue(P, lds, wave, lane); }
    xcd_barrier(bar);
    if (threadIdx.x == 0) { volatile LAS unsigned* z_ = (volatile LAS unsigned*)(lds + LDS_BYTES - 256); bool uni_ = (G % 8) == 0;
        for (int j = 0; j < 8; ++j) uni_ = uni_ && (xb_ld(bar.bar + XB_XCNT(j)) == (unsigned)(G / 8));
        z_[17] = uni_ ? z_[16] : blockIdx.x; }
    __syncthreads();
    const int vcu = __builtin_amdgcn_readfirstlane((int)((volatile LAS unsigned*)(lds + LDS_BYTES - 256))[17]);
    { PHASE_IDS(); PHASE_PTRS();
      constexpr int NTAILU = ((MT - MAIN_ROWS) / 256) * (INC / 256);
      if (vcu < NTAILU) {
          pg8::Gemm g{XN, WinT, MT, INC, DM, DM}; pg8::TailOrder S; S.init(MAIN_ROWS / 256, (MT - MAIN_ROWS) / 256, INC / 256, 1, NTAILU, vcu);
          EpiInProj E{(bf16*)(P.ws + WS_R), (bf16*)(P.ws + WS_R + QSZ), (bf16*)(P.ws + WS_R + 2 * QSZ), (bf16*)(P.ws + WS_R + 3 * QSZ), P.out};
          pg8::gemm_phase<EpiInProj, pg8::TailOrder, true, true>(lds, g, S, E, tid);
          __syncthreads(); }
      p0b_queue(P, lds, ctl + 3072, wave, lane); }
    xcd_barrier(bar);
    REP(1) { PHASE_IDS(); PHASE_PTRS(); pg8::Gemm g{XN, WinT, MAIN_ROWS, INC, DM, DM}; pg8::StaticOrder S; S.init(MAIN_ROWS, INC, G, vcu);
      EpiInProj E{(bf16*)(P.ws + WS_R), (bf16*)(P.ws + WS_R + QSZ), (bf16*)(P.ws + WS_R + 2 * QSZ), (bf16*)(P.ws + WS_R + 3 * QSZ), P.out};
      pg8::gemm_phase<EpiInProj, pg8::StaticOrder, true, true>(lds, g, S, E, tid); }
    xcd_barrier(bar);
    {
        PHASE_IDS(); PHASE_PTRS();
        LAS unsigned char* wl = lds + wave * WAVE_LDS;
        const int myx = (int)(xb_xcc_id() & 7u);
        for (int ra = 0; ra < ((PROBE_DUP == 2 || PROBE_DUP == 8) ? 2 : 1); ++ra)
        for (int qi = 0; qi < NH; ++qi) { const int hq = (myx + qi) & 7;
            unsigned* qc = ctl + 256 + 64 * hq + 1024 * ra;
            int item = 0;
            if (lane == 0) item = (int)atomicAdd(qc, 1u);
            item = __builtin_amdgcn_readfirstlane(item);
            while (item < ATT_PER_HEAD) {
                int nraw = 0;
                if (lane == 0) nraw = (int)atomicAdd(qc, 1u);
                attn_item(hq * ATT_PER_HEAD + item, P, wl, lane);
                item = __builtin_amdgcn_readfirstlane(nraw);
            } }
        __syncthreads();
        for (int rc = 0; rc < ((PROBE_DUP == 2 || PROBE_DUP == 9) ? 2 : 1); ++rc) { conv_phase(P, lds, ctl + 64 + 128 * rc, tid, wave, lane); __syncthreads(); }
    }
    xcd_barrier(bar);
    REP(3) {
    { PHASE_IDS(); PHASE_PTRS(); pg8::Gemm g{ATT, WoutT, MAIN_ROWS, DM, DM, DM}; pg8::StaticOrder S; S.init(MAIN_ROWS, DM, G, vcu);
      EpiX1 E{XN, X1B, STAT};
      pg8::gemm_phase<EpiX1, pg8::StaticOrder, true, true>(lds, g, S, E, tid); }
    { PHASE_IDS(); PHASE_PTRS(); pg8::Gemm g{ATT, WoutT, MT, DM, DM / TAIL_S, DM}; pg8::TailOrder S; S.init(MAIN_ROWS / 256, (MT - MAIN_ROWS) / 256, DM / 256, TAIL_S, G, vcu);
      EpiPart E{PART};
      pg8::gemm_phase<EpiPart, pg8::TailOrder, true, true>(lds, g, S, E, tid); }
    }
    xcd_barrier(bar);
    REP(4) { PHASE_IDS(); PHASE_PTRS(); const int gw = blockIdx.x * NWAVES + wave, NGW = G * NWAVES;
      for (int r = MAIN_ROWS + gw; r < MT; r += NGW) { f32x4 v[4]; load_row_bf16(XN + (size_t)r * DM, lane, v);
#pragma unroll
          for (int j = 0; j < 4; ++j) v[j] = v[j] * ALPHA;
          add_partials(PART + (size_t)(r - MAIN_ROWS) * DM, lane, v); store_row_bf16(X1B + (size_t)r * DM, lane, v);
          float s = 0.f, q = 0.f;
#pragma unroll
          for (int j = 0; j < 4; ++j) { const float a = bflo(pk2(v[j].x, 0.f)), b = bflo(pk2(v[j].y, 0.f)), c = bflo(pk2(v[j].z, 0.f)), d = bflo(pk2(v[j].w, 0.f)); s += (a + b) + (c + d); q += (a * a + b * b) + (c * c + d * d); }
          s = wave_sum(s); q = wave_sum(q);
          if (lane == 0) { STAT[2 * (size_t)r] = s; STAT[2 * (size_t)r + 1] = q; } } }
    xcd_barrier(bar);
    REP(5) { PHASE_IDS(); PHASE_PTRS(); pg8::Gemm g{X1B, W1T, MT, DFF, DM, DM}; pg8::StaticOrder S; S.init(MT, DFF, G, vcu);
      EpiFF1 E{F, STAT, C1, C2};
      pg8::gemm_phase<EpiFF1, pg8::StaticOrder, true, true>(lds, g, S, E, tid); }
    xcd_barrier(bar);
    REP(6) {
    { PHASE_IDS(); PHASE_PTRS(); pg8::Gemm g{F, W2T, MAIN_ROWS, DM, DFF, DFF}; pg8::StaticOrder S; S.init(MAIN_ROWS, DM, G, vcu);
      EpiY2 E{X1B, Y2B, STAT, P.g1, P.b1};
      pg8::gemm_phase<EpiY2, pg8::StaticOrder, true, true>(lds, g, S, E, tid); }
    { PHASE_IDS(); PHASE_PTRS(); pg8::Gemm g{F, W2T, MT, DM, DFF / TAIL_S, DFF}; pg8::TailOrder S; S.init(MAIN_ROWS / 256, (MT - MAIN_ROWS) / 256, DM / 256, TAIL_S, G, vcu);
      EpiPart E{PART};
      pg8::gemm_phase<EpiPart, pg8::TailOrder, true, true>(lds, g, S, E, tid); }
    }
    xcd_barrier(bar);
    { PHASE_IDS(); PHASE_PTRS(); const int gw = blockIdx.x * NWAVES + wave, NGW = G * NWAVES; constexpr int NY = NB * SEQ + MS;
      auto y_load = [&](int m, f32x4 (&v)[4]) {
          const int r = m < NB * SEQ ? (m >> 11) * LP + NMETA + (m & (SEQ - 1)) : MP + (m - NB * SEQ);
          if (r < MAIN_ROWS) load_row_bf16(Y2B + (size_t)r * DM, lane, v);
          else { load_row_bf16(X1B + (size_t)r * DM, lane, v); float mean, rstd; stat_mr(STAT, r, mean, rstd); affine_row(mean, rstd, P.g1, P.b1, lane, v);
#pragma unroll
              for (int j = 0; j < 4; ++j) v[j] = v[j] * ALPHA;
              add_partials(PART + (size_t)(r - MAIN_ROWS) * DM, lane, v); } };
      auto y_store = [&](int m, f32x4 (&v)[4]) { float* row = P.out + (size_t)m * DM;
#pragma unroll
          for (int j = 0; j < 4; ++j) __builtin_nontemporal_store(v[j], (f32x4*)row + lane + 64 * j); };
      for (int m = gw; m < NY; m += 2 * NGW) {
          const int m1 = m + NGW; const bool has1 = m1 < NY;
          f32x4 v0[4], v1[4];
          y_load(m, v0); if (has1) y_load(m1, v1);
          ln_apply(P.g2, P.b2, lane, v0); y_store(m, v0);
          if (has1) { ln_apply(P.g2, P.b2, lane, v1); y_store(m1, v1); } } }
}

extern "C" void kernel_launch(void* const* d_in, const int* in_sizes, int n_in, void* d_out, int out_size, void* d_ws, size_t ws_size, hipStream_t stream) {
    static int grid = 0;
    if (grid == 0) {
        if (n_in != 20 || (size_t)out_size != OUT_TOTAL || ws_size < WS_END3) { fprintf(stderr, "kernel_launch: unexpected problem: n_in %d out %d ws %zu (need %zu)\n", n_in, out_size, ws_size, (size_t)WS_END3); grid = -1; return; }
        int dev = 0, cus = 0, per_cu = 0;
        if (hipGetDevice(&dev) != hipSuccess || hipDeviceGetAttribute(&cus, hipDeviceAttributeMultiprocessorCount, dev) != hipSuccess) { grid = -1; return; }
        if (hipFuncSetAttribute((const void*)hymba_fwd, hipFuncAttributeMaxDynamicSharedMemorySize, LDS_BYTES) != hipSuccess) { fprintf(stderr, "kernel_launch: hipFuncSetAttribute failed\n"); grid = -1; return; }
        if (hipOccupancyMaxActiveBlocksPerMultiprocessor(&per_cu, (const void*)hymba_fwd, NTHREADS, LDS_BYTES) != hipSuccess || per_cu < 1) { fprintf(stderr, "kernel_launch: occupancy query says %d\n", per_cu); (void)hipGetLastError(); per_cu = 1; }
        if (per_cu > 1) per_cu = 1;
        grid = cus * per_cu;
    }
    if (grid < 0) return;
    (void)hipMemsetAsync((char*)d_ws + WS_CTL, 0, CTL_BYTES, stream);
    Params p{};
    p.x_prompt = (const float*)d_in[0]; p.x_sample = (const float*)d_in[1]; p.cache_k = (const float*)d_in[2]; p.cache_v = (const float*)d_in[3]; p.state_conv = (const float*)d_in[4];
    p.meta = (const float*)d_in[5]; p.g_in = (const float*)d_in[6]; p.b_in = (const float*)d_in[7]; p.w_in = (const float*)d_in[8]; p.w_dw = (const float*)d_in[9]; p.b_dw = (const float*)d_in[10];
    p.g_conv = (const float*)d_in[11]; p.b_conv = (const float*)d_in[12]; p.w_out = (const float*)d_in[13]; p.g1 = (const float*)d_in[14]; p.b1 = (const float*)d_in[15];
    p.w_ff1 = (const float*)d_in[16]; p.w_ff2 = (const float*)d_in[17]; p.g2 = (const float*)d_in[18]; p.b2 = (const float*)d_in[19];
    p.out = (float*)d_out; p.ws = (unsigned char*)d_ws;
    void* args[] = {&p};
    hipError_t e = hipLaunchCooperativeKernel((const void*)hymba_fwd, dim3(grid), dim3(NTHREADS), args, LDS_BYTES, stream);
    if (e != hipSuccess) fprintf(stderr, "kernel_launch: cooperative launch failed: %s (grid %d)\n", hipGetErrorString(e), grid);
}
```
